# Optimizing an MI355X kernel written in HIP

```python
import math
import jax, jax.numpy as jnp
from jax import lax
import numpy as np

D_MODEL = 1024
BATCH = 32
SEQ = 2048
DEPTH = 4

CTX_LEN = 256
GRID_W = 64
N_MIXERS = 4
QBLOCK = 128
ROPE_THETA = 10000.0
NORM_EPS = 1e-6
LN_EPS = 1e-5
N_MOD = 6
A_HEADS = 16
A_KV_HEADS = 4
A_HEAD_DIM = 64
B_HEADS = 8
B_HEAD_DIM = 64
C_HEADS = 4
C_KEY_DIM = D_MODEL // 2
C_VAL_DIM = D_MODEL
C_GATE_RANK = 16
C_GATE_NORMALIZER = 16.0
C_CHUNK = 64
D_HEADS = 16
D_HEAD_DIM = 64
WIN_R = 8
WIN_C = 16
FF_DIM = 2816
CONV_W = 3
DEEPNORM_ALPHA = (2 * DEPTH) ** 0.25
DEEPNORM_BETA = (8 * DEPTH) ** -0.25

kernel_name = "hybrid_diffusion_interleaved_block"


def rms_norm(x, g, eps=NORM_EPS):
    xf = x.astype(jnp.float32)
    y = xf * lax.rsqrt(jnp.mean(xf * xf, axis=-1, keepdims=True) + eps)
    return (y * g.astype(jnp.float32)).astype(x.dtype)


def layer_norm(x, g, b):
    xf = x.astype(jnp.float32)
    mu = jnp.mean(xf, axis=-1, keepdims=True)
    var = jnp.mean(jnp.square(xf - mu), axis=-1, keepdims=True)
    y = (xf - mu) * lax.rsqrt(var + LN_EPS)
    return (y * g.astype(jnp.float32) + b.astype(jnp.float32)).astype(x.dtype)


def _split_heads(x, n_heads):
    b, l, _ = x.shape
    return x.reshape(b, l, n_heads, -1).transpose(0, 2, 1, 3)


def _merge_heads(x):
    b, h, l, d = x.shape
    return x.transpose(0, 2, 1, 3).reshape(b, l, h * d)


def _softmax32(s):
    return jax.nn.softmax(s.astype(jnp.float32), axis=-1)


def axial_rope(n_tokens, head_dim):
    t = jnp.arange(n_tokens)
    row = (t // GRID_W).astype(jnp.float32)
    col = (t % GRID_W).astype(jnp.float32)
    n_freq = head_dim // 4
    inv = 1.0 / (ROPE_THETA ** (jnp.arange(n_freq, dtype=jnp.float32) / n_freq))
    ang = jnp.concatenate([row[:, None] * inv, col[:, None] * inv], axis=-1)
    return jnp.cos(ang), jnp.sin(ang)


def apply_rope(x, cos, sin):
    half = x.shape[-1] // 2
    x1 = x[..., :half].astype(jnp.float32)
    x2 = x[..., half:].astype(jnp.float32)
    return jnp.concatenate([x1 * cos - x2 * sin, x1 * sin + x2 * cos], axis=-1).astype(x.dtype)


def sweep_query_blocks(fn, qs):
    n = qs[0].shape[-2]
    nb = n // QBLOCK

    def split(a):
        a = a.reshape(a.shape[:-2] + (nb, QBLOCK, a.shape[-1]))
        return jnp.moveaxis(a, -3, 0)

    out = lax.map(lambda blk: fn(*blk), tuple(split(a) for a in qs))
    out = jnp.moveaxis(out, 0, -3)
    return out.reshape(out.shape[:-3] + (n, out.shape[-1]))


def gqa_mixer(h_lat, h_ctx, w_qkv, q_norm, k_norm, w_o, cos, sin, with_ctx_out):
    hq, hkv, d = A_HEADS, A_KV_HEADS, A_HEAD_DIM
    grp = hq // hkv
    scale = d ** -0.5
    cuts = [hq * d, hq * d + hkv * d]

    def project(h):
        q, k, v = jnp.split(h @ w_qkv, cuts, axis=-1)
        return _split_heads(q, hq), rms_norm(_split_heads(k, hkv), k_norm), _split_heads(v, hkv)

    q_l, k_l, v_l = project(h_lat)
    q_c, k_c, v_c = project(h_ctx)
    q_l = apply_rope(rms_norm(q_l, q_norm), cos, sin)
    k_l = apply_rope(k_l, cos, sin)
    k_all = jnp.concatenate([k_c, k_l], axis=2)
    v_all = jnp.concatenate([v_c, v_l], axis=2)

    def attend(q, k, v):
        s = jnp.einsum("bkgqd,bkld->bkgql", q, k).astype(jnp.float32) * scale
        p = _softmax32(s).astype(v.dtype)
        return jnp.einsum("bkgql,bkld->bkgqd", p, v)

    bsz, _, n_lat, _ = q_l.shape
    o_l = sweep_query_blocks(lambda qb: attend(qb, k_all, v_all),
                             (q_l.reshape(bsz, hkv, grp, n_lat, d),))
    y_lat = _merge_heads(o_l.reshape(bsz, hq, n_lat, d)) @ w_o
    if not with_ctx_out:
        return y_lat, None
    n_ctx = q_c.shape[2]
    q_c = rms_norm(q_c, q_norm).reshape(bsz, hkv, grp, n_ctx, d)
    o_c = attend(q_c, k_c, v_c)
    y_ctx = _merge_heads(o_c.reshape(bsz, hq, n_ctx, d)) @ w_o
    return y_lat, y_ctx


def diff_mixer(h_lat, h_ctx, w_qkv, lam_q1, lam_k1, lam_q2, lam_k2, subln, w_o,
               cos, sin, layer_idx, with_ctx_out):
    nh, d = B_HEADS, B_HEAD_DIM
    scale = d ** -0.5
    lam_init = 0.8 - 0.6 * math.exp(-0.3 * layer_idx)
    lam = (jnp.exp(jnp.sum(lam_q1.astype(jnp.float32) * lam_k1.astype(jnp.float32)))
           - jnp.exp(jnp.sum(lam_q2.astype(jnp.float32) * lam_k2.astype(jnp.float32)))
           + lam_init)
    cuts = [2 * nh * d, 4 * nh * d]

    def project(h):
        bsz, n, _ = h.shape
        q, k, v = jnp.split(h @ w_qkv, cuts, axis=-1)
        q = q.reshape(bsz, n, nh, 2, d).transpose(3, 0, 2, 1, 4)
        k = k.reshape(bsz, n, nh, 2, d).transpose(3, 0, 2, 1, 4)
        return q, k, _split_heads(v, nh)

    q_l, k_l, v_l = project(h_lat)
    q_c, k_c, v_c = project(h_ctx)
    q_l = apply_rope(q_l, cos, sin)
    k_l = apply_rope(k_l, cos, sin)
    k_all = jnp.concatenate([k_c, k_l], axis=3)
    v_all = jnp.concatenate([v_c, v_l], axis=2)

    def attend(q1, q2, k, v):
        s1 = jnp.einsum("bhqd,bhld->bhql", q1, k[0]).astype(jnp.float32) * scale
        s2 = jnp.einsum("bhqd,bhld->bhql", q2, k[1]).astype(jnp.float32) * scale
        p = _softmax32(s1) - lam * _softmax32(s2)
        return jnp.einsum("bhql,bhle->bhqe", p.astype(v.dtype), v)

    def finish(o):
        return _merge_heads(rms_norm(o, subln) * (1.0 - lam_init)) @ w_o

    o_l = sweep_query_blocks(lambda a, b: attend(a, b, k_all, v_all), (q_l[0], q_l[1]))
    y_lat = finish(o_l)
    if not with_ctx_out:
        return y_lat, None
    y_ctx = finish(attend(q_c[0], q_c[1], k_c, v_c))
    return y_lat, y_ctx


def gla_chunk_scan(q, k, v, g, s0):
    bsz, nh, n_tok, _ = q.shape
    nc = n_tok // C_CHUNK

    def chunks(a):
        return jnp.moveaxis(a.reshape(bsz, nh, nc, C_CHUNK, a.shape[-1]), 2, 0)

    tri = jnp.tril(jnp.ones((C_CHUNK, C_CHUNK), dtype=bool))

    def step(s, blk):
        qc, kc, vc, gc = blk
        b = jnp.cumsum(gc, axis=-2)
        b_last = b[:, :, -1:, :]
        o_inter = jnp.einsum("bhld,bhdv->bhlv", qc * jnp.exp(b), s)
        rel = b[:, :, :, None, :] - b[:, :, None, :, :]
        decay = jnp.exp(jnp.where(tri[:, :, None], rel, -jnp.inf))
        a = jnp.einsum("bhid,bhjd,bhijd->bhij", qc, kc, decay)
        o = o_inter + jnp.einsum("bhij,bhjv->bhiv", a, vc)
        s = (s * jnp.exp(b_last)[:, :, 0, :, None]
             + jnp.einsum("bhld,bhlv->bhdv", kc * jnp.exp(b_last - b), vc))
        return s, o

    s, o = lax.scan(step, s0, (chunks(q), chunks(k), chunks(v), chunks(g)))
    o = jnp.moveaxis(o, 0, 2).reshape(bsz, nh, n_tok, v.shape[-1])
    return o, s


def gla_final_state(k, v, g):
    b = jnp.cumsum(g, axis=-2)
    return jnp.einsum("bhtd,bhtv->bhdv", k * jnp.exp(b[:, :, -1:, :] - b), v)


def gla_mixer(h_lat, h_ctx, w_in, w_gate_fwd, b_gate_fwd, w_gate_bwd, b_gate_bwd,
              norm_g, w_o, with_ctx_out):
    nh = C_HEADS
    dk, dv = C_KEY_DIM // nh, C_VAL_DIM // nh
    cuts = np.cumsum([C_KEY_DIM, C_KEY_DIM, C_VAL_DIM, C_VAL_DIM, C_GATE_RANK]).tolist()

    def heads32(a):
        return _split_heads(a, nh).astype(jnp.float32)

    def log_gate(z, w, b):
        return heads32(jax.nn.log_sigmoid((z @ w + b).astype(jnp.float32)) / C_GATE_NORMALIZER)

    def project(h):
        q, k, v, og, zf, zb = jnp.split(h @ w_in, cuts, axis=-1)
        return (heads32(q) * dk ** -0.5, heads32(k), heads32(v),
                log_gate(zf, w_gate_fwd, b_gate_fwd), log_gate(zb, w_gate_bwd, b_gate_bwd), og)

    def flip(a):
        return jnp.flip(a, axis=2)

    def finish(o, og):
        o = _merge_heads(rms_norm(o, norm_g)).astype(og.dtype)
        return (o * jax.nn.silu(og)) @ w_o

    q_l, k_l, v_l, gf_l, gb_l, og_l = project(h_lat)
    q_c, k_c, v_c, gf_c, gb_c, og_c = project(h_ctx)
    zero = jnp.zeros((q_l.shape[0], nh, dk, dv), jnp.float32)
    if with_ctx_out:
        o_cf, s_f = gla_chunk_scan(q_c, k_c, v_c, gf_c, zero)
        o_cb, s_b = gla_chunk_scan(flip(q_c), flip(k_c), flip(v_c), flip(gb_c), zero)
        y_ctx = finish(o_cf + flip(o_cb), og_c)
    else:
        s_f = gla_final_state(k_c, v_c, gf_c)
        s_b = gla_final_state(flip(k_c), flip(v_c), flip(gb_c))
        y_ctx = None
    o_lf, _ = gla_chunk_scan(q_l, k_l, v_l, gf_l, s_f)
    o_lb, _ = gla_chunk_scan(flip(q_l), flip(k_l), flip(v_l), flip(gb_l), s_b)
    y_lat = finish(o_lf + flip(o_lb), og_l)
    return y_lat, y_ctx


def neighbourhood_mixer(h_lat, h_ctx, w_qkv, rpb, w_o, with_ctx_out):
    nh, d = D_HEADS, D_HEAD_DIM
    scale = d ** -0.5
    cuts = [nh * d, 2 * nh * d]

    def project(h):
        q, k, v = jnp.split(h @ w_qkv, cuts, axis=-1)
        return _split_heads(q, nh), _split_heads(k, nh), _split_heads(v, nh)

    q_l, k_l, v_l = project(h_lat)
    q_c, k_c, v_c = project(h_ctx)
    bsz, _, n_lat, _ = q_l.shape
    rows = n_lat // GRID_W
    wr = min(WIN_R, rows)

    def grid(a):
        return a.reshape(bsz, nh, rows, GRID_W, d)

    k_g, v_g = grid(k_l), grid(v_l)
    cq = np.arange(GRID_W)
    c0 = np.clip(cq - WIN_C // 2, 0, GRID_W - WIN_C)
    col_in = (cq[None, :] >= c0[:, None]) & (cq[None, :] < c0[:, None] + WIN_C)
    dc_idx = np.clip(cq[None, :] - cq[:, None], -(WIN_C - 1), WIN_C - 1) + WIN_C - 1
    n_band = wr * GRID_W

    def row_block(r, q_r):
        r0 = jnp.clip(r - wr // 2, 0, rows - wr)
        k_band = lax.dynamic_slice_in_dim(k_g, r0, wr, axis=2)
        v_band = lax.dynamic_slice_in_dim(v_g, r0, wr, axis=2)
        dr_idx = r0 + jnp.arange(wr) - r + (WIN_R - 1)
        bias = jnp.take(rpb, dr_idx, axis=1)[:, :, dc_idx]
        bias = bias.transpose(0, 2, 1, 3).astype(jnp.float32)
        s_nb = jnp.einsum("bhqd,bhrkd->bhqrk", q_r, k_band).astype(jnp.float32) * scale + bias
        s_nb = jnp.where(col_in[:, None, :], s_nb, -jnp.inf).reshape(bsz, nh, GRID_W, n_band)
        s_c = jnp.einsum("bhqd,bhcd->bhqc", q_r, k_c).astype(jnp.float32) * scale
        p = _softmax32(jnp.concatenate([s_nb, s_c], axis=-1)).astype(v_l.dtype)
        p_nb = p[..., :n_band].reshape(bsz, nh, GRID_W, wr, GRID_W)
        return (jnp.einsum("bhqrk,bhrkd->bhqd", p_nb, v_band)
                + jnp.einsum("bhqc,bhcd->bhqd", p[..., n_band:], v_c))

    q_rows = jnp.moveaxis(grid(q_l), 2, 0)
    o = lax.map(lambda a: row_block(*a), (jnp.arange(rows), q_rows))
    o = jnp.moveaxis(o, 0, 2).reshape(bsz, nh, n_lat, d)
    y_lat = _merge_heads(o) @ w_o
    if not with_ctx_out:
        return y_lat, None
    s = jnp.einsum("bhqd,bhcd->bhqc", q_c, k_c).astype(jnp.float32) * scale
    o_c = jnp.einsum("bhqc,bhcd->bhqd", _softmax32(s).astype(v_c.dtype), v_c)
    return y_lat, _merge_heads(o_c) @ w_o


def dwconv_centred(u, w, b):
    pad = CONV_W // 2
    n = u.shape[1]
    up = jnp.pad(u, ((0, 0), (pad, pad), (0, 0)))
    out = b
    for j in range(CONV_W):
        out = out + up[:, j:j + n] * w[j]
    return out


def conv_ffn(h, w_up, conv_w, conv_b, w_down):
    u = dwconv_centred(h @ w_up, conv_w, conv_b)
    gate, val = jnp.split(u, 2, axis=-1)
    return (jax.nn.silu(gate) * val) @ w_down


def _n_of(kind):
    return len(range(kind, DEPTH, N_MIXERS))


def setup_inputs(seed: int = 0) -> dict:
    key = jax.random.key(seed)
    ks = iter(jax.random.split(key, 48))

    def nrm(shape, scale):
        return jax.random.normal(next(ks), shape, jnp.float32) * scale

    D = D_MODEL
    na, nb, nc, nd = _n_of(0), _n_of(1), _n_of(2), _n_of(3)
    beta = DEEPNORM_BETA
    return {
        "x": nrm((BATCH, SEQ, D), 1.0),
        "c": nrm((BATCH, D), 1.0),
        "ctx": nrm((BATCH, CTX_LEN, D), 1.0),
        "c_ctx": nrm((D,), 1.0),
        "mod_w": nrm((DEPTH, D, N_MOD * D), 0.5 * D ** -0.5),
        "mod_b": nrm((DEPTH, N_MOD * D), 0.02),
        "ln1_g": 1.0 + nrm((DEPTH, D), 0.02),
        "ln1_b": nrm((DEPTH, D), 0.02),
        "ffn_w_up": nrm((DEPTH, D, 2 * FF_DIM), D ** -0.5),
        "ffn_conv_w": nrm((DEPTH, CONV_W, 2 * FF_DIM), CONV_W ** -0.5),
        "ffn_conv_b": nrm((DEPTH, 2 * FF_DIM), 0.02),
        "ffn_w_down": nrm((DEPTH, FF_DIM, D), beta * FF_DIM ** -0.5),
        "ln2_g": 1.0 + nrm((DEPTH, D), 0.02),
        "ln2_b": nrm((DEPTH, D), 0.02),
        "a_w_qkv": nrm((na, D, (A_HEADS + 2 * A_KV_HEADS) * A_HEAD_DIM), D ** -0.5),
        "a_q_norm": 1.0 + nrm((na, A_HEAD_DIM), 0.02),
        "a_k_norm": 1.0 + nrm((na, A_HEAD_DIM), 0.02),
        "a_w_o": nrm((na, A_HEADS * A_HEAD_DIM, D), beta * (A_HEADS * A_HEAD_DIM) ** -0.5),
        "b_w_qkv": nrm((nb, D, 6 * B_HEADS * B_HEAD_DIM), D ** -0.5),
        "b_lambda_q1": nrm((nb, B_HEAD_DIM), 0.1),
        "b_lambda_k1": nrm((nb, B_HEAD_DIM), 0.1),
        "b_lambda_q2": nrm((nb, B_HEAD_DIM), 0.1),
        "b_lambda_k2": nrm((nb, B_HEAD_DIM), 0.1),
        "b_subln": 1.0 + nrm((nb, 2 * B_HEAD_DIM), 0.02),
        "b_w_o": nrm((nb, 2 * B_HEADS * B_HEAD_DIM, D), beta * (2 * B_HEADS * B_HEAD_DIM) ** -0.5),
        "c_w_in": nrm((nc, D, 2 * C_KEY_DIM + 2 * C_VAL_DIM + 2 * C_GATE_RANK), D ** -0.5),
        "c_w_gate_fwd": nrm((nc, C_GATE_RANK, C_KEY_DIM), C_GATE_RANK ** -0.5),
        "c_b_gate_fwd": nrm((nc, C_KEY_DIM), 0.02),
        "c_w_gate_bwd": nrm((nc, C_GATE_RANK, C_KEY_DIM), C_GATE_RANK ** -0.5),
        "c_b_gate_bwd": nrm((nc, C_KEY_DIM), 0.02),
        "c_norm": 1.0 + nrm((nc, C_VAL_DIM // C_HEADS), 0.02),
        "c_w_o": nrm((nc, C_VAL_DIM, D), beta * C_VAL_DIM ** -0.5),
        "d_w_qkv": nrm((nd, D, 3 * D_HEADS * D_HEAD_DIM), D ** -0.5),
        "d_rpb": nrm((nd, D_HEADS, 2 * WIN_R - 1, 2 * WIN_C - 1), 0.02),
        "d_w_o": nrm((nd, D_HEADS * D_HEAD_DIM, D), beta * (D_HEADS * D_HEAD_DIM) ** -0.5),
    }


def reference(x, c, ctx, c_ctx, mod_w, mod_b, ln1_g, ln1_b, ffn_w_up, ffn_conv_w,
              ffn_conv_b, ffn_w_down, ln2_g, ln2_b,
              a_w_qkv, a_q_norm, a_k_norm, a_w_o,
              b_w_qkv, b_lambda_q1, b_lambda_k1, b_lambda_q2, b_lambda_k2, b_subln, b_w_o,
              c_w_in, c_w_gate_fwd, c_b_gate_fwd, c_w_gate_bwd, c_b_gate_bwd, c_norm, c_w_o,
              d_w_qkv, d_rpb, d_w_o):
    bsz, n_lat, dm = x.shape
    cos, sin = axial_rope(n_lat, A_HEAD_DIM)
    cond_lat = jax.nn.silu(c)
    cond_ctx = jax.nn.silu(c_ctx)
    alpha = DEEPNORM_ALPHA
    x_lat, x_ctx = x, ctx
    for i in range(DEPTH):
        kind, j = i % N_MIXERS, i // N_MIXERS
        last = i == DEPTH - 1
        m_lat = (cond_lat @ mod_w[i] + mod_b[i]).reshape(bsz, N_MOD, 1, dm)
        n_ctx_mod = 3 if last else N_MOD
        m_ctx = (cond_ctx @ mod_w[i][:, :n_ctx_mod * dm] + mod_b[i][:n_ctx_mod * dm]).reshape(n_ctx_mod, dm)
        h_lat = x_lat * (1.0 + m_lat[:, 1]) + m_lat[:, 0]
        h_ctx = x_ctx * (1.0 + m_ctx[1]) + m_ctx[0]
        if kind == 0:
            y_lat, y_ctx = gqa_mixer(h_lat, h_ctx, a_w_qkv[j], a_q_norm[j], a_k_norm[j], a_w_o[j],
                                     cos, sin, not last)
        elif kind == 1:
            y_lat, y_ctx = diff_mixer(h_lat, h_ctx, b_w_qkv[j], b_lambda_q1[j], b_lambda_k1[j],
                                      b_lambda_q2[j], b_lambda_k2[j], b_subln[j], b_w_o[j],
                                      cos, sin, i, not last)
        elif kind == 2:
            y_lat, y_ctx = gla_mixer(h_lat, h_ctx, c_w_in[j], c_w_gate_fwd[j], c_b_gate_fwd[j],
                                     c_w_gate_bwd[j], c_b_gate_bwd[j], c_norm[j], c_w_o[j], not last)
        else:
            y_lat, y_ctx = neighbourhood_mixer(h_lat, h_ctx, d_w_qkv[j], d_rpb[j], d_w_o[j], not last)
        x_lat = layer_norm(alpha * x_lat + m_lat[:, 2] * y_lat, ln1_g[i], ln1_b[i])
        h_lat = x_lat * (1.0 + m_lat[:, 4]) + m_lat[:, 3]
        f_lat = conv_ffn(h_lat, ffn_w_up[i], ffn_conv_w[i], ffn_conv_b[i], ffn_w_down[i])
        x_lat = layer_norm(alpha * x_lat + m_lat[:, 5] * f_lat, ln2_g[i], ln2_b[i])
        if not last:
            x_ctx = layer_norm(alpha * x_ctx + m_ctx[2] * y_ctx, ln1_g[i], ln1_b[i])
            h_ctx = x_ctx * (1.0 + m_ctx[4]) + m_ctx[3]
            f_ctx = conv_ffn(h_ctx, ffn_w_up[i], ffn_conv_w[i], ffn_conv_b[i], ffn_w_down[i])
            x_ctx = layer_norm(alpha * x_ctx + m_ctx[5] * f_ctx, ln2_g[i], ln2_b[i])
    return x_lat
```

```cpp
#include <hip/hip_runtime.h>
#include <hip/hip_cooperative_groups.h>
#include <cstdio>
#include <cstdint>
#include <cstring>
namespace cg = cooperative_groups;

typedef unsigned short bf16_t;
typedef short bf16x8 __attribute__((ext_vector_type(8)));
typedef float f32x2 __attribute__((ext_vector_type(2)));
typedef float f32x4 __attribute__((ext_vector_type(4)));
typedef float f32x16 __attribute__((ext_vector_type(16)));
typedef unsigned u32x4 __attribute__((ext_vector_type(4)));
typedef unsigned u32x2 __attribute__((ext_vector_type(2)));
typedef __bf16 bf16x2_t __attribute__((ext_vector_type(2)));
#define DI __device__ __forceinline__

constexpr int DM = 1024, NB = 32, TL = 2048, CL = 256, TP = 2304;
constexpr int MLAT = NB * TL, MCTX = NB * CL, MTOT = MLAT + MCTX;
constexpr int FF = 2816;
constexpr int NTHREADS = 256;
#ifndef DUP_MASK
#define DUP_MASK 0
#endif
#define REPS(bit) (((DUP_MASK >> (bit)) & 1) + 1)
constexpr int SMEM_BYTES = 81408;
constexpr float LOG2E = 1.4426950408889634f;
constexpr float DN_ALPHA = 1.681792830507429f;
constexpr float LAM_INIT_B = 0.35550906759096934f;

constexpr size_t MiB = 1024ull * 1024ull;
constexpr size_t OFF_MOD = 0;
constexpr size_t OFF_ROPE = 3 * MiB + 512 * 1024;
constexpr size_t OFF_ZROW = 3 * MiB + 768 * 1024;
constexpr size_t OFF_BAR = 3 * MiB + 896 * 1024;
constexpr size_t OFF_ZB = 4 * MiB;
constexpr size_t OFF_XC = 13 * MiB;
constexpr size_t OFF_WT = 45 * MiB;
constexpr size_t OFF_H = 141 * MiB;
constexpr size_t OFF_Y = 285 * MiB;
constexpr size_t OFF_QKV = 429 * MiB;
constexpr size_t WS_NEED = 879 * MiB;

struct Params {
  const float* in[35];
  float* out;
  unsigned char* ws;
  const float* wsrc[16];
  long wdst[16];
  int wK[16], wN[16], wNpad[16], wmode[16], wtile0[17];
  int pad_;
};

enum { I_X = 0, I_C, I_CTX, I_CCTX, I_MODW, I_MODB, I_LN1G, I_LN1B, I_UPW, I_CONVW, I_CONVB, I_DOWNW, I_LN2G, I_LN2B,
       I_AQKV, I_AQN, I_AKN, I_AWO, I_BQKV, I_BLQ1, I_BLK1, I_BLQ2, I_BLK2, I_BSUB, I_BWO,
       I_CWIN, I_CGF, I_CBF, I_CGB, I_CBB, I_CNORM, I_CWO, I_DQKV, I_DRPB, I_DWO };

DI unsigned pk2(float a, float b) { f32x2 v = {a, b}; bf16x2_t r = __builtin_convertvector(v, bf16x2_t); return __builtin_bit_cast(unsigned, r); }
DI float bf2f(unsigned v) { return __uint_as_float(v << 16); }
DI float bflo(unsigned v) { return __uint_as_float(v << 16); }
DI float bfhi(unsigned v) { return __uint_as_float(v & 0xffff0000u); }
DI f32x4 mfma16(bf16x8 a, bf16x8 b, f32x4 c) { return __builtin_amdgcn_mfma_f32_16x16x32_bf16(a, b, c, 0, 0, 0); }
DI f32x16 mfma32(bf16x8 a, bf16x8 b, f32x16 c) { return __builtin_amdgcn_mfma_f32_32x32x16_bf16(a, b, c, 0, 0, 0); }
DI float fexp2(float x) { return __builtin_amdgcn_exp2f(x); }
DI float silu_f(float x) { return x * __builtin_amdgcn_rcpf(1.0f + __expf(-x)); }
DI int urow_to_p(int r) { return r < MLAT ? (r >> 11) * TP + CL + (r & 2047) : ((r - MLAT) >> 8) * TP + ((r - MLAT) & 255); }
DI int get_tid() { int t = threadIdx.x; asm volatile("" : "+v"(t)); return t; }
DI int get_bid() { int t = blockIdx.x; asm volatile("" : "+v"(t)); return __builtin_amdgcn_readfirstlane(t); }
DI int launder(int t) { asm volatile("" : "+v"(t)); return t; }
DI float shx(float v, int mask, int lane) { return __builtin_bit_cast(float, __builtin_amdgcn_ds_bpermute((lane ^ mask) << 2, __builtin_bit_cast(int, v))); }
DI int iclamp(int v, int lo, int hi) { return v < lo ? lo : (v > hi ? hi : v); }

DI void mod_item(const Params& p, int item, unsigned char* smem) {
  const int tid = get_tid(), lane = tid & 63, w = tid >> 6;
  const int li = item / 96, cg_ = item % 96;
  const int n = cg_ * 64 + lane;
  const float* W = p.in[I_MODW] + (size_t)li * DM * 6144;
  const float* c = p.in[I_C];
  const float* cc = p.in[I_CCTX];
  float* sc = (float*)smem + w * (64 * 36);
  float acc[33];
#pragma unroll
  for (int r = 0; r < 33; ++r) acc[r] = 0.f;
  for (int kc = 0; kc < 4; ++kc) {
    const int kb = w * 256 + kc * 64;
#pragma unroll
    for (int r = 0; r < 33; ++r) {
      float v = (r < 32) ? c[r * DM + kb + lane] : cc[kb + lane];
      sc[lane * 36 + r] = silu_f(v);
    }
    __builtin_amdgcn_s_waitcnt(0);
    __builtin_amdgcn_wave_barrier();
#pragma unroll 4
    for (int kk = 0; kk < 64; ++kk) {
      const float wv = __builtin_nontemporal_load(W + (size_t)(kb + kk) * 6144 + n);
      const float* s = sc + kk * 36;
#pragma unroll
      for (int r4 = 0; r4 < 8; ++r4) {
        f32x4 cv = *(const f32x4*)(s + r4 * 4);
        acc[r4 * 4 + 0] += cv[0] * wv; acc[r4 * 4 + 1] += cv[1] * wv; acc[r4 * 4 + 2] += cv[2] * wv; acc[r4 * 4 + 3] += cv[3] * wv;
      }
      acc[32] += s[32] * wv;
    }
    __builtin_amdgcn_wave_barrier();
  }
  __syncthreads();
  float* red = (float*)smem;
#pragma unroll
  for (int r = 0; r < 33; ++r) red[(w * 33 + r) * 64 + lane] = acc[r];
  __syncthreads();
  const float* bias = p.in[I_MODB] + (size_t)li * 6144;
  float* MOD = (float*)(p.ws + OFF_MOD) + (size_t)li * 33 * 6144;
  for (int e = tid; e < 33 * 64; e += NTHREADS) {
    const int r = e >> 6, l = e & 63;
    float v = red[(0 * 33 + r) * 64 + l] + red[(1 * 33 + r) * 64 + l] + red[(2 * 33 + r) * 64 + l] + red[(3 * 33 + r) * 64 + l];
    MOD[(size_t)r * 6144 + cg_ * 64 + l] = v + bias[cg_ * 64 + l];
  }
  __syncthreads();
}

DI void rope_item(const Params& p) {
  float* ROPE = (float*)(p.ws + OFF_ROPE);
  for (int e = get_tid(); e < 1024; e += NTHREADS) ((unsigned*)(p.ws + OFF_ZROW))[e] = 0u;
  const double INV[16] = {1.0, 0.5623413251903491, 0.31622776601683794, 0.1778279410038923, 0.1, 0.05623413251903491, 0.03162277660168379,
                          0.01778279410038923, 0.01, 0.005623413251903491, 0.0031622776601683794, 0.0017782794100389228, 0.001,
                          0.0005623413251903491, 0.00031622776601683794, 0.00017782794100389227};
  for (int e = get_tid(); e < 1024; e += NTHREADS) {
    const int pos = e >> 4, j = e & 15;
    double inv = 1.0;
#pragma unroll
    for (int q = 0; q < 16; ++q) inv = (j == q) ? INV[q] : inv;
    const double a = (double)pos * inv;
    const double n = __builtin_rint(a * 0.6366197723675814);
    double r = __builtin_fma(-n, 1.5707963267948966, a);
    r = __builtin_fma(-n, 6.123233995736766e-17, r);
    const double r2 = r * r;
    double sn = -1.0 / 1307674368000.0;
    sn = sn * r2 + 1.0 / 6227020800.0; sn = sn * r2 - 1.0 / 39916800.0; sn = sn * r2 + 1.0 / 362880.0; sn = sn * r2 - 1.0 / 5040.0;
    sn = sn * r2 + 1.0 / 120.0; sn = sn * r2 - 1.0 / 6.0; sn = sn * r2 + 1.0; sn = sn * r;
    double cs = 1.0 / 20922789888000.0;
    cs = cs * r2 - 1.0 / 87178291200.0; cs = cs * r2 + 1.0 / 479001600.0; cs = cs * r2 - 1.0 / 3628800.0; cs = cs * r2 + 1.0 / 40320.0;
    cs = cs * r2 - 1.0 / 720.0; cs = cs * r2 + 1.0 / 24.0; cs = cs * r2 - 0.5; cs = cs * r2 + 1.0;
    const int q4 = ((int)n) & 3;
    double so, co;
    if (q4 == 0) { so = sn; co = cs; } else if (q4 == 1) { so = cs; co = -sn; } else if (q4 == 2) { so = -sn; co = -cs; } else { so = -cs; co = sn; }
    ROPE[e * 2] = (float)co; ROPE[e * 2 + 1] = (float)so;
  }
}

DI void transpose_item(const Params& p, int t, unsigned char* smem) {
  int mi = 0;
#pragma unroll
  for (int q = 1; q < 16; ++q) mi = (t >= p.wtile0[q]) ? q : mi;
  const int lt = t - p.wtile0[mi];
  const int K = p.wK[mi], N = p.wN[mi], Npad = p.wNpad[mi], mode = p.wmode[mi];
  const int ntn = Npad >> 6;
  const int tk = lt / ntn, tn = lt % ntn;
  const float* W = p.wsrc[mi];
  bf16_t* WT = (bf16_t*)(p.ws + OFF_WT) + p.wdst[mi];
  float* tile = (float*)smem;
  const int tid = get_tid();
  {
    const int j4 = tid & 15, i4 = tid >> 4;
    const int n4 = tn * 64 + 4 * j4;
    f32x4 t4[4];
#pragma unroll
    for (int ps = 0; ps < 4; ++ps)
      t4[ps] = (n4 < N) ? __builtin_nontemporal_load((const f32x4*)(W + (size_t)(tk * 64 + ps * 16 + i4) * N + n4)) : (f32x4){0.f, 0.f, 0.f, 0.f};
#pragma unroll
    for (int ps = 0; ps < 4; ++ps) {
      float* tr = tile + (ps * 16 + i4) * 65 + 4 * j4;
      tr[0] = t4[ps][0]; tr[1] = t4[ps][1]; tr[2] = t4[ps][2]; tr[3] = t4[ps][3];
    }
  }
  __syncthreads();
  int nd0 = tn * 64;
  if (mode == 1) nd0 = (tn < 44) ? tn * 128 : (tn - 44) * 128 + 64;
  const int nl = tid >> 2, kq = tid & 3;
  unsigned w8[8];
#pragma unroll
  for (int e = 0; e < 8; ++e) {
    int k0 = kq * 16 + 2 * e, k1 = k0 + 1;
    if (mode == 2) { k0 = ((k0 >> 2) & 1) * 32 + (k0 >> 3) * 4 + (k0 & 3); k1 = ((k1 >> 2) & 1) * 32 + (k1 >> 3) * 4 + (k1 & 3); }
    w8[e] = pk2(tile[k0 * 65 + nl], tile[k1 * 65 + nl]);
  }
  u32x4* dst = (u32x4*)(WT + (size_t)(nd0 + nl) * K + tk * 64 + kq * 16);
  dst[0] = (u32x4){w8[0], w8[1], w8[2], w8[3]};
  dst[1] = (u32x4){w8[4], w8[5], w8[6], w8[7]};
  __syncthreads();
}

DI void modulate_phase(const Params& p) {
  const int tid_ = get_tid(); const int lane = tid_ & 63, wv = get_bid() * 4 + (tid_ >> 6), nw = gridDim.x * 4;
  const float* MOD = (const float*)(p.ws + OFF_MOD);
  bf16_t* H = (bf16_t*)(p.ws + OFF_H);
  auto segment = [&](int base, int count, int mrow) {
    const float* m = MOD + (size_t)mrow * 6144;
    f32x4 shr_[4], scr[4];
#pragma unroll
    for (int j = 0; j < 4; ++j) { const int c = j * 256 + lane * 4; shr_[j] = *(const f32x4*)(m + c); scr[j] = *(const f32x4*)(m + 1024 + c) + 1.0f; }
    for (int i = 0; i < count; ++i) {
      const int r = base + i;
      const float* x = r < MLAT ? p.in[I_X] + (size_t)r * DM : p.in[I_CTX] + (size_t)(r - MLAT) * DM;
#pragma unroll
      for (int j = 0; j < 4; ++j) {
        const int c = j * 256 + lane * 4;
        f32x4 xv = __builtin_nontemporal_load((const f32x4*)(x + c));
        f32x4 h = xv * scr[j] + shr_[j];
        *(u32x2*)(H + (size_t)r * DM + c) = (u32x2){pk2(h[0], h[1]), pk2(h[2], h[3])};
      }
    }
  };
  if ((nw & 31) == 0 && (2048 % (nw >> 5)) == 0) {
    const int wpb = nw >> 5, rpw = 2048 / wpb;
    const int bb_ = wv / wpb, wi = wv - bb_ * wpb;
    segment(bb_ * 2048 + wi * rpw, rpw, bb_);
  } else {
    for (int r = wv; r < MLAT; r += nw) segment(r, 1, r >> 11);
  }
  {
    const int per = (MCTX + nw - 1) / nw;
    const int c0 = wv * per;
    if (c0 < MCTX) segment(MLAT + c0, (c0 + per <= MCTX) ? per : MCTX - c0, 32);
  }
}

DI void ln_phase(const Params& p, const float* xs_lat, const float* xs_ctx, float* xd_lat, float* xd_ctx, const float* modg, int gidx,
                 const float* lg, const float* lb, const float* modh, int shidx, int scidx, int nrows, bool write_h) {
  const int tid_ = get_tid(); const int lane = tid_ & 63, wv = get_bid() * 4 + (tid_ >> 6), nw = gridDim.x * 4;
  const bf16_t* Y = (const bf16_t*)(p.ws + OFF_Y);
  bf16_t* H = (bf16_t*)(p.ws + OFF_H);
  f32x4 ggr[4], bbr[4];
#pragma unroll
  for (int j = 0; j < 4; ++j) { ggr[j] = *(const f32x4*)(lg + (j >> 1) * 512 + lane * 8 + (j & 1) * 4); bbr[j] = *(const f32x4*)(lb + (j >> 1) * 512 + lane * 8 + (j & 1) * 4); }
  auto segment = [&](int base, int count, int mrow) {
    f32x4 gvr[4], shr_[4], scr[4];
    const float* mg = modg + (size_t)mrow * 6144 + gidx * 1024;
    const float* mh = modh + (size_t)mrow * 6144;
#pragma unroll
    for (int j = 0; j < 4; ++j) {
      const int c = (j >> 1) * 512 + lane * 8 + (j & 1) * 4;
      gvr[j] = *(const f32x4*)(mg + c);
      if (write_h) { shr_[j] = *(const f32x4*)(mh + shidx * 1024 + c); scr[j] = *(const f32x4*)(mh + scidx * 1024 + c) + 1.0f; }
    }
    for (int i = 0; i < count; i += 2) {
      const float* x[2]; float* xd[2]; int rr[2]; bool ok[2];
      f32x4 v[2][4];
      float s[2];
#pragma unroll
      for (int u = 0; u < 2; ++u) {
        ok[u] = i + u < count;
        rr[u] = base + (ok[u] ? i + u : i);
        const bool lat = rr[u] < MLAT;
        x[u] = lat ? xs_lat + (size_t)rr[u] * DM : xs_ctx + (size_t)(rr[u] - MLAT) * DM;
        xd[u] = lat ? xd_lat + (size_t)rr[u] * DM : xd_ctx + (size_t)(rr[u] - MLAT) * DM;
      }
#pragma unroll
      for (int u = 0; u < 2; ++u) {
        s[u] = 0.f;
#pragma unroll
        for (int jh = 0; jh < 2; ++jh) {
          const int c = jh * 512 + lane * 8;
          f32x4 xa = __builtin_nontemporal_load((const f32x4*)(x[u] + c)), xb = __builtin_nontemporal_load((const f32x4*)(x[u] + c + 4));
          u32x4 yv = __builtin_nontemporal_load((const u32x4*)(Y + (size_t)rr[u] * DM + c));
          f32x4 ya = {bflo(yv[0]), bfhi(yv[0]), bflo(yv[1]), bfhi(yv[1])}, yb = {bflo(yv[2]), bfhi(yv[2]), bflo(yv[3]), bfhi(yv[3])};
          v[u][2 * jh] = xa * DN_ALPHA + gvr[2 * jh] * ya;
          v[u][2 * jh + 1] = xb * DN_ALPHA + gvr[2 * jh + 1] * yb;
          s[u] += ((v[u][2 * jh][0] + v[u][2 * jh][1]) + (v[u][2 * jh][2] + v[u][2 * jh][3])) + ((v[u][2 * jh + 1][0] + v[u][2 * jh + 1][1]) + (v[u][2 * jh + 1][2] + v[u][2 * jh + 1][3]));
        }
      }
#pragma unroll
      for (int o = 32; o >= 1; o >>= 1) { s[0] += shx(s[0], o, lane); s[1] += shx(s[1], o, lane); }
      float mu[2], q[2];
#pragma unroll
      for (int u = 0; u < 2; ++u) {
        mu[u] = s[u] * (1.0f / 1024.0f); q[u] = 0.f;
#pragma unroll
        for (int j = 0; j < 4; ++j) { f32x4 d = v[u][j] - mu[u]; q[u] += (d[0] * d[0] + d[1] * d[1]) + (d[2] * d[2] + d[3] * d[3]); }
      }
#pragma unroll
      for (int o = 32; o >= 1; o >>= 1) { q[0] += shx(q[0], o, lane); q[1] += shx(q[1], o, lane); }
#pragma unroll
      for (int u = 0; u < 2; ++u) {
        if (!ok[u]) continue;
        const float rstd = rsqrtf(q[u] * (1.0f / 1024.0f) + 1e-5f);
#pragma unroll
        for (int jh = 0; jh < 2; ++jh) {
          const int c = jh * 512 + lane * 8;
          f32x4 oa = (v[u][2 * jh] - mu[u]) * rstd * ggr[2 * jh] + bbr[2 * jh];
          f32x4 ob = (v[u][2 * jh + 1] - mu[u]) * rstd * ggr[2 * jh + 1] + bbr[2 * jh + 1];
          __builtin_nontemporal_store(oa, (f32x4*)(xd[u] + c));
          __builtin_nontemporal_store(ob, (f32x4*)(xd[u] + c + 4));
          if (write_h) {
            f32x4 ha = oa * scr[2 * jh] + shr_[2 * jh], hb = ob * scr[2 * jh + 1] + shr_[2 * jh + 1];
            *(u32x4*)(H + (size_t)rr[u] * DM + c) = (u32x4){pk2(ha[0], ha[1]), pk2(ha[2], ha[3]), pk2(hb[0], hb[1]), pk2(hb[2], hb[3])};
          }
        }
      }
    }
  };
  if ((nw & 31) == 0 && (2048 % (nw >> 5)) == 0) {
    const int wpb = nw >> 5, rpw = 2048 / wpb;
    const int bb_ = wv / wpb, wi = wv - bb_ * wpb;
    segment(bb_ * 2048 + wi * rpw, rpw, bb_);
  } else {
    for (int r = wv; r < MLAT; r += nw) segment(r, 1, r >> 11);
  }
  if (nrows > MLAT) {
    const int nctx = nrows - MLAT;
    const int per = (nctx + nw - 1) / nw;
    const int c0 = wv * per;
    if (c0 < nctx) segment(MLAT + c0, (c0 + per <= nctx) ? per : nctx - c0, 32);
  }
}

DI void gla_finish_phase(const Params& p) {
  const int tid_ = get_tid(); const int lane = tid_ & 63, wv = get_bid() * 4 + (tid_ >> 6), nw = gridDim.x * 4;
  bf16_t* OF = (bf16_t*)(p.ws + OFF_H);
  const bf16_t* OB = (const bf16_t*)(p.ws + OFF_Y);
  const bf16_t* OG = (const bf16_t*)(p.ws + OFF_QKV) + (size_t)MTOT * 512 * 2 + (size_t)NB * 1024 * TP;
  const float* ng = p.in[I_CNORM];
  float gpr[16];
#pragma unroll
  for (int e4 = 0; e4 < 4; ++e4) { f32x4 t = *(const f32x4*)(ng + (lane & 15) * 16 + e4 * 4); gpr[e4 * 4] = t[0]; gpr[e4 * 4 + 1] = t[1]; gpr[e4 * 4 + 2] = t[2]; gpr[e4 * 4 + 3] = t[3]; }
  for (int r = wv; r < MTOT; r += nw) {
    const size_t off = (size_t)r * DM + lane * 16;
    float o[16], g[16];
#pragma unroll
    for (int h2 = 0; h2 < 2; ++h2) {
      u32x4 a = __builtin_nontemporal_load((const u32x4*)(OF + off + h2 * 8)), b = __builtin_nontemporal_load((const u32x4*)(OB + off + h2 * 8)), c = __builtin_nontemporal_load((const u32x4*)(OG + off + h2 * 8));
#pragma unroll
      for (int e = 0; e < 4; ++e) {
        o[h2 * 8 + 2 * e] = bflo(a[e]) + bflo(b[e]); o[h2 * 8 + 2 * e + 1] = bfhi(a[e]) + bfhi(b[e]);
        g[h2 * 8 + 2 * e] = bflo(c[e]); g[h2 * 8 + 2 * e + 1] = bfhi(c[e]);
      }
    }
    float ss = 0.f;
#pragma unroll
    for (int e = 0; e < 16; ++e) ss += o[e] * o[e];
    ss += shx(ss, 1, lane); ss += shx(ss, 2, lane); ss += shx(ss, 4, lane); ss += shx(ss, 8, lane);
    const float rinv = rsqrtf(ss * (1.0f / 256.0f) + 1e-6f);
    unsigned w[8];
#pragma unroll
    for (int e = 0; e < 8; ++e) {
      float v0 = o[2 * e] * rinv * gpr[2 * e] * silu_f(g[2 * e]);
      float v1 = o[2 * e + 1] * rinv * gpr[2 * e + 1] * silu_f(g[2 * e + 1]);
      w[e] = pk2(v0, v1);
    }
    *(u32x4*)(OF + off) = (u32x4){w[0], w[1], w[2], w[3]};
    *(u32x4*)(OF + off + 8) = (u32x4){w[4], w[5], w[6], w[7]};
  }
}

constexpr int GB_BUF = 128 * 80;
template <bool SW>
DI void gemm_kloop(f32x4 (&acc)[4][8], const bf16_t* Abase, const unsigned (&aoff)[4], const bf16_t* Bg, int K, unsigned char* smem) {
  const int tid = get_tid(), lane = tid & 63, fr = lane & 15, fq = lane >> 4;
  const int brow = tid >> 2, bch = tid & 3;
  const int nk = K >> 5;
  const unsigned boff0 = (unsigned)((brow * K + bch * 8) * 2), boff1 = boff0 + (unsigned)(64 * K * 2);
  const unsigned char* Ab = (const unsigned char*)Abase;
  const unsigned char* Bb = (const unsigned char*)Bg;
  unsigned char* bdst = smem + brow * 80 + bch * 16;
  const unsigned char* bs = smem + fr * 80 + fq * 16;
  bf16x8 a0[4], a1[4];
  u32x4 rb[2];
#define G_LOADA(dst, kt) _Pragma("unroll") for (int m = 0; m < 4; ++m) { dst[m] = *(const bf16x8*)(Ab + (aoff[m] + (unsigned)(kt) * 64u)); }
#define G_LOADB(kt) { rb[0] = *(const u32x4*)(Bb + (boff0 + (unsigned)(kt) * 64u)); rb[1] = *(const u32x4*)(Bb + (boff1 + (unsigned)(kt) * 64u)); }
#define G_STOREB(buf) { *(u32x4*)(bdst + (buf) * GB_BUF) = rb[0]; *(u32x4*)(bdst + (buf) * GB_BUF + 64 * 80) = rb[1]; }
#define G_COMPUTE(af, buf) _Pragma("unroll") for (int nh = 0; nh < 2; ++nh) { \
    bf16x8 bfr[4]; \
    _Pragma("unroll") for (int n = 0; n < 4; ++n) bfr[n] = *(const bf16x8*)(bs + (buf) * GB_BUF + (nh * 4 + n) * 16 * 80); \
    __builtin_amdgcn_s_setprio(1); \
    _Pragma("unroll") for (int m = 0; m < 4; ++m) \
    _Pragma("unroll") for (int n = 0; n < 4; ++n) acc[m][nh * 4 + n] = SW ? mfma16(bfr[n], af[m], acc[m][nh * 4 + n]) : mfma16(af[m], bfr[n], acc[m][nh * 4 + n]); \
    __builtin_amdgcn_s_setprio(0); }
  G_LOADA(a0, 0); G_LOADB(0); G_STOREB(0); __syncthreads();
  for (int kt = 0; kt < nk; kt += 2) {
    G_LOADA(a1, kt + 1); G_LOADB(kt + 1);
    G_COMPUTE(a0, 0);
    G_STOREB(1);
    __syncthreads();
    if (kt + 2 < nk) { G_LOADA(a0, kt + 2); G_LOADB(kt + 2); }
    G_COMPUTE(a1, 1);
    if (kt + 2 < nk) G_STOREB(0);
    __syncthreads();
  }
#undef G_LOADA
#undef G_LOADB
#undef G_STOREB
#undef G_COMPUTE
}

constexpr int GBF_BUF = 128 * 144;
template <bool SW, bool DB = false>
DI void gemm_kloopF(f32x4 (&acc)[4][8], const bf16_t* Abase, const unsigned (&aoff)[4], const bf16_t* Bg, int K, unsigned char* smem) {
  const int tid = get_tid(), lane = tid & 63, fr = lane & 15, fq = lane >> 4;
  const int brow = tid >> 3, bch = tid & 7;
  const int nk = K >> 6;
  const unsigned boff = (unsigned)((brow * K + bch * 8) * 2), bstep = (unsigned)(32 * K * 2);
  const unsigned char* Ab = (const unsigned char*)Abase;
  const unsigned char* Bb = (const unsigned char*)Bg;
  unsigned char* bdst = smem + brow * 144 + bch * 16;
  const unsigned char* bs = smem + fr * 144 + fq * 16;
  bf16x8 X[4], Y[4], Z[4];
  u32x4 rb[2];
#define G_LOADG(D, g, ks) { \
    D[0] = *(const bf16x8*)(Ab + (aoff[2 * (g)] + (unsigned)(ks) * 128u)); D[1] = *(const bf16x8*)(Ab + (aoff[2 * (g)] + (unsigned)(ks) * 128u + 64u)); \
    D[2] = *(const bf16x8*)(Ab + (aoff[2 * (g) + 1] + (unsigned)(ks) * 128u)); D[3] = *(const bf16x8*)(Ab + (aoff[2 * (g) + 1] + (unsigned)(ks) * 128u + 64u)); }
#define G_LOADB(ks, h) _Pragma("unroll") for (int j = 0; j < 2; ++j) rb[j] = *(const u32x4*)(Bb + (boff + (unsigned)(2 * (h) + j) * bstep + (unsigned)(ks) * 128u));
#define G_STOREB(buf, h) _Pragma("unroll") for (int j = 0; j < 2; ++j) *(u32x4*)(bdst + (buf) * GBF_BUF + (2 * (h) + j) * 32 * 144) = rb[j];
#define G_BLD(dst, buf, q) _Pragma("unroll") for (int n = 0; n < 4; ++n) dst[n] = *(const bf16x8*)(bs + (buf) * GBF_BUF + ((((q) & 1) * 4 + n) * 16 * 144) + ((q) >> 1) * 64);
#define G_MM(D, g, bfr, q) _Pragma("unroll") for (int mm = 0; mm < 2; ++mm) \
    _Pragma("unroll") for (int n = 0; n < 4; ++n) acc[2 * (g) + mm][((q) & 1) * 4 + n] = SW ? mfma16(bfr[n], D[2 * mm + ((q) >> 1)], acc[2 * (g) + mm][((q) & 1) * 4 + n]) : mfma16(D[2 * mm + ((q) >> 1)], bfr[n], acc[2 * (g) + mm][((q) & 1) * 4 + n]);
#define G_COMPG(D, g, buf) { if (!DB) { _Pragma("unroll") for (int q = 0; q < 4; ++q) { \
      __builtin_amdgcn_sched_barrier(0); \
      bf16x8 bfr[4]; G_BLD(bfr, buf, q); G_MM(D, g, bfr, q); } \
    } else { \
      bf16x8 b0[4], b1[4]; \
      __builtin_amdgcn_sched_barrier(0); G_BLD(b0, buf, 0); \
      __builtin_amdgcn_sched_barrier(0); G_BLD(b1, buf, 1); G_MM(D, g, b0, 0); \
      __builtin_amdgcn_sched_barrier(0); G_BLD(b0, buf, 2); G_MM(D, g, b1, 1); \
      __builtin_amdgcn_sched_barrier(0); G_BLD(b1, buf, 3); G_MM(D, g, b0, 2); \
      __builtin_amdgcn_sched_barrier(0); G_MM(D, g, b1, 3); } }
#define G_STEP(C0, C1, SP, ks) { \
    const bool more_ = (ks) + 1 < nk; \
    if (more_) { G_LOADB((ks) + 1, 0); G_LOADG(SP, 0, (ks) + 1); } \
    G_COMPG(C0, 0, (ks) & 1); \
    if (more_) { G_STOREB(((ks) + 1) & 1, 0); G_LOADB((ks) + 1, 1); G_LOADG(C0, 1, (ks) + 1); } \
    G_COMPG(C1, 1, (ks) & 1); \
    if (more_) { G_STOREB(((ks) + 1) & 1, 1); } \
    __syncthreads(); }
  G_LOADG(X, 0, 0); G_LOADG(Y, 1, 0); G_LOADB(0, 0); G_STOREB(0, 0); G_LOADB(0, 1); G_STOREB(0, 1); __syncthreads();
  for (int ks = 0; ks < nk; ks += 3) {
    G_STEP(X, Y, Z, ks);
    if (ks + 1 < nk) G_STEP(Z, X, Y, ks + 1);
    if (ks + 2 < nk) G_STEP(Y, Z, X, ks + 2);
  }
#undef G_STEP
#undef G_COMPG
#undef G_MM
#undef G_BLD
#undef G_STOREB
#undef G_LOADB
#undef G_LOADG
}

DI void tile_remap(int L, int nM, int nN, int& pm, int& pn) {
  const int nwg = nM * nN;
  int wgid = L;
  { const int q = nwg / 8, r = nwg % 8, xcd = wgid % 8, off = wgid / 8; wgid = (xcd < r ? xcd * (q + 1) : r * (q + 1) + (xcd - r) * q) + off; }
  const int nig = 8 * nN, gid = wgid / nig, fm = gid * 8, gsz = (nM - fm) < 8 ? (nM - fm) : 8;
  pm = fm + ((wgid % nig) % gsz); pn = (wgid % nig) / gsz;
}

#define ACC_ZERO(acc) _Pragma("unroll") for (int m = 0; m < 4; ++m) _Pragma("unroll") for (int n = 0; n < 8; ++n) acc[m][n] = (f32x4){0.f, 0.f, 0.f, 0.f};

DI void gemm_plain_phase(const Params& p, const bf16_t* A, int K, const bf16_t* Bt, bf16_t* C, int nM, unsigned char* smem) {
  const int tid = get_tid(), lane = tid & 63, wid = tid >> 6, fr = lane & 15, fq = lane >> 4;
  const int nN = 8, nwg = nM * nN;
  for (int L = get_bid(); L < nwg; L += gridDim.x) {
    int pm, pn; tile_remap(L, nM, nN, pm, pn);
    const int rowbase = pm * 256 + wid * 64;
    unsigned aoff[4];
#pragma unroll
    for (int m = 0; m < 4; ++m) aoff[m] = (unsigned)(((rowbase + m * 16 + fr) * K + fq * 8)) * 2u;
    f32x4 acc[4][8];
    ACC_ZERO(acc);
    gemm_kloopF<true, true>(acc, A, aoff, Bt + (size_t)pn * 128 * K, K, smem);
    unsigned char* Tw = smem + wid * 17408;
#pragma unroll
    for (int m = 0; m < 4; ++m)
#pragma unroll
      for (int n = 0; n < 8; ++n)
        *(u32x2*)(Tw + (m * 16 + fr) * 272 + (n * 16 + 4 * fq) * 2) = (u32x2){pk2(acc[m][n][0], acc[m][n][1]), pk2(acc[m][n][2], acc[m][n][3])};
    __builtin_amdgcn_sched_barrier(0);
#pragma unroll 2
    for (int it = 0; it < 16; ++it) {
      const int row = it * 4 + (lane >> 4), ch = lane & 15;
      *(u32x4*)(C + (size_t)(rowbase + row) * 1024 + pn * 128 + ch * 8) = *(const u32x4*)(Tw + row * 272 + ch * 16);
    }
    __syncthreads();
  }
}

struct QkvCfg { int kind, nq, nk, nv, ntiles; float qscale; };
DI void gemm_qkv_phase(const Params& p, const QkvCfg cfg, const bf16_t* Bt, const float* qn, const float* kn, unsigned char* smem) {
  const int tid = get_tid(), lane = tid & 63, wid = tid >> 6, fr = lane & 15, fq = lane >> 4;
  const bf16_t* A = (const bf16_t*)(p.ws + OFF_H);
  bf16_t* Qb = (bf16_t*)(p.ws + OFF_QKV);
  bf16_t* Kb = Qb + (size_t)MTOT * cfg.nq;
  bf16_t* VTb = Kb + (size_t)MTOT * cfg.nk;
  bf16_t* OGb = VTb + (size_t)NB * cfg.nv * TP;
  float* ZB = (float*)(p.ws + OFF_ZB);
  const float* ROPE = (const float*)(p.ws + OFF_ROPE);
  const int nM = MTOT / 256, nN = cfg.ntiles, nwg = nM * nN;
  const int K = 1024;
  const int v0c = cfg.nq + cfg.nk, v1c = v0c + cfg.nv;
  for (int L = get_bid(); L < nwg; L += gridDim.x) {
    int pm, pn; tile_remap(L, nM, nN, pm, pn);
    const int rowbase = pm * 256 + wid * 64;
    unsigned aoff[4];
#pragma unroll
    for (int m = 0; m < 4; ++m) aoff[m] = (unsigned)(((rowbase + m * 16 + fr) * K + fq * 8)) * 2u;
    f32x4 acc[4][8];
    ACC_ZERO(acc);
    const int col0 = pn * 128;
    if (cfg.kind == 3 && pm * 256 >= MLAT && col0 < cfg.nq) continue;
    const bool vtile = (col0 >= v0c) && (col0 < v1c);
    if (vtile) {
      gemm_kloopF<false, false>(acc, A, aoff, Bt + (size_t)pn * 128 * K, K, smem);
      unsigned char* Tv = smem + wid * 18432;
#pragma unroll
      for (int m = 0; m < 4; ++m)
#pragma unroll
        for (int n = 0; n < 8; ++n)
          *(u32x2*)(Tv + (n * 16 + fr) * 144 + (m * 16 + 4 * fq) * 2) = (u32x2){pk2(acc[m][n][0], acc[m][n][1]), pk2(acc[m][n][2], acc[m][n][3])};
      __builtin_amdgcn_sched_barrier(0);
      {
        const int P0 = urow_to_p(rowbase);
        const int b = P0 / TP, kidx0 = P0 - b * TP;
        bf16_t* dst0 = VTb + ((size_t)(b * cfg.nv + (col0 - v0c))) * TP + kidx0;
#pragma unroll 2
        for (int it = 0; it < 16; ++it) {
          const int vc = it * 8 + (lane >> 3), ch = lane & 7;
          __builtin_nontemporal_store(*(const u32x4*)(Tv + vc * 144 + ch * 16), (u32x4*)(dst0 + (size_t)vc * TP + ch * 8));
        }
      }
    } else {
      gemm_kloop<true>(acc, A, aoff, Bt + (size_t)pn * 128 * K, K, smem);
      const bool isq = col0 < cfg.nq, isk = (!isq) && col0 < v0c;
      const bool isz = (!isq) && (!isk) && !(col0 < v1c + 1024);
      unsigned char* Tw = smem + wid * 17408;
      const bool lat = pm * 256 < MLAT;
      const bool do_rms = (cfg.kind == 0) && (isq || isk);
      const bool do_rope = (cfg.kind <= 1) && (isq || isk) && lat;
      const float scl = isq ? cfg.qscale : 1.0f;
      const float* nw = isq ? qn : kn;
#pragma unroll
      for (int hd = 0; hd < 2; ++hd) {
        const int cw = col0 + hd * 64;
#pragma unroll
        for (int m = 0; m < 4; ++m) {
          __builtin_amdgcn_sched_barrier(0);
          const int ur = rowbase + m * 16 + fr;
          const int P = urow_to_p(ur);
          float v[4][4];
#pragma unroll
          for (int n = 0; n < 4; ++n)
#pragma unroll
            for (int r = 0; r < 4; ++r) v[n][r] = acc[m][hd * 4 + n][r];
          if (do_rms) {
            float ss = 0.f;
#pragma unroll
            for (int n = 0; n < 4; ++n)
#pragma unroll
              for (int r = 0; r < 4; ++r) ss += v[n][r] * v[n][r];
            ss += shx(ss, 16, lane); ss += shx(ss, 32, lane);
            const float rinv = rsqrtf(ss * (1.0f / 64.0f) + 1e-6f);
#pragma unroll
            for (int n = 0; n < 4; ++n) {
              f32x4 g = *(const f32x4*)(nw + n * 16 + 4 * fq);
#pragma unroll
              for (int r = 0; r < 4; ++r) v[n][r] = v[n][r] * rinv * g[r];
            }
          }
          if (do_rope) {
            const int t = ur & 2047;
            const int prow = t >> 6, pcol = t & 63;
#pragma unroll
            for (int n = 0; n < 2; ++n) {
              const int pos = n == 0 ? prow : pcol;
              const float* rp = ROPE + (pos * 16 + 4 * fq) * 2;
              f32x4 c0 = *(const f32x4*)(rp), c1 = *(const f32x4*)(rp + 4);
              const float cs[4] = {c0[0], c0[2], c1[0], c1[2]}, sn[4] = {c0[1], c0[3], c1[1], c1[3]};
#pragma unroll
              for (int r = 0; r < 4; ++r) {
                const float x1 = v[n][r], x2 = v[n + 2][r];
                v[n][r] = x1 * cs[r] - x2 * sn[r];
                v[n + 2][r] = x1 * sn[r] + x2 * cs[r];
              }
            }
          }
          if (!isz) {
#pragma unroll
            for (int n = 0; n < 4; ++n)
              *(u32x2*)(Tw + (m * 16 + fr) * 272 + (hd * 64 + n * 16 + 4 * fq) * 2) = (u32x2){pk2(v[n][0] * scl, v[n][1] * scl), pk2(v[n][2] * scl, v[n][3] * scl)};
          } else {
            if (hd == 0) {
#pragma unroll
              for (int n = 0; n < 2; ++n) *(f32x4*)(ZB + (size_t)P * 32 + n * 16 + 4 * fq) = (f32x4){v[n][0], v[n][1], v[n][2], v[n][3]};
            }
          }
        }
      }
      __builtin_amdgcn_sched_barrier(0);
      if (!isz) {
        bf16_t* dst0;
        int ld;
        if (isq) { dst0 = Qb + (size_t)urow_to_p(rowbase) * cfg.nq + col0; ld = cfg.nq; }
        else if (isk) { dst0 = Kb + (size_t)urow_to_p(rowbase) * cfg.nk + (col0 - cfg.nq); ld = cfg.nk; }
        else { dst0 = OGb + (size_t)rowbase * 1024 + (col0 - v1c); ld = 1024; }
#pragma unroll 2
        for (int it = 0; it < 16; ++it) {
          const int row = it * 4 + (lane >> 4), ch = lane & 15;
          __builtin_nontemporal_store(*(const u32x4*)(Tw + row * 272 + ch * 16), (u32x4*)(dst0 + (size_t)row * ld + ch * 8));
        }
      }
    }
    __syncthreads();
  }
}

DI float dpp_prev(float v) { float o; asm volatile("v_mov_b32_dpp %0, %1 row_ror:1 row_mask:0xf bank_mask:0xf" : "=v"(o) : "v"(v)); return o; }
DI float dpp_next(float v) { float o; asm volatile("v_mov_b32_dpp %0, %1 row_ror:15 row_mask:0xf bank_mask:0xf" : "=v"(o) : "v"(v)); return o; }
DI void gemm_ffn_up_phase(const Params& p, int layer, const bf16_t* Bt, bool with_ctx, unsigned char* smem) {
  const int tid = get_tid(), lane = tid & 63, wid = tid >> 6, fr = lane & 15, fq = lane >> 4;
  bf16_t* U = (bf16_t*)(p.ws + OFF_QKV);
  const bf16_t* ZROW = (const bf16_t*)(p.ws + OFF_ZROW);
  const float* cw = p.in[I_CONVW] + (size_t)layer * 3 * 5632;
  const float* cb = p.in[I_CONVB] + (size_t)layer * 5632;
  const int nM = with_ctx ? 292 : 259, nN = 44, nwg = nM * nN;
  const int K = 1024;
  for (int L = get_bid(); L < nwg; L += gridDim.x) {
    int pm, pn; tile_remap(L, nM, nN, pm, pn);
    int sbase, slen, sqm, kk;
    if (pm < 259) { kk = pm; sbase = 0; slen = MLAT; sqm = 2047; } else { kk = pm - 259; sbase = MLAT; slen = MCTX; sqm = 255; }
    const int t0 = 254 * kk - 1;
    unsigned aoff[4];
#pragma unroll
    for (int m = 0; m < 4; ++m) {
      const int t = t0 + wid * 64 + m * 16 + fr;
      const bool ok = (t >= 0) && (t < slen);
      aoff[m] = ok ? (unsigned)(OFF_H - OFF_ZROW) + (unsigned)(((sbase + t) * K + fq * 8)) * 2u : (unsigned)(fq * 16);
    }
    f32x4 acc[4][8];
    ACC_ZERO(acc);
    gemm_kloopF<true, true>(acc, ZROW, aoff, Bt + (size_t)pn * 128 * K, K, smem);
    {
      float* Tall = (float*)smem;
      float* Tw = Tall + wid * (64 * 68);
      const int c4 = (lane & 7) * 4, i0 = (lane >> 3) * 8;
#pragma unroll
      for (int hf = 0; hf < 2; ++hf) {
        __builtin_amdgcn_sched_barrier(0);
#pragma unroll
        for (int m = 0; m < 4; ++m)
#pragma unroll
          for (int j = 0; j < 2; ++j) {
            *(f32x4*)(Tw + (m * 16 + fr) * 68 + j * 16 + 4 * fq) = acc[m][2 * hf + j];
            *(f32x4*)(Tw + (m * 16 + fr) * 68 + 32 + j * 16 + 4 * fq) = acc[m][4 + 2 * hf + j];
          }
        __syncthreads();
        const int cgi = pn * 64 + hf * 32 + c4, cvi = FF + cgi;
        const f32x4 g0 = *(const f32x4*)(cw + cgi), g1 = *(const f32x4*)(cw + 5632 + cgi), g2 = *(const f32x4*)(cw + 2 * 5632 + cgi), gb = *(const f32x4*)(cb + cgi);
        const f32x4 v0 = *(const f32x4*)(cw + cvi), v1 = *(const f32x4*)(cw + 5632 + cvi), v2 = *(const f32x4*)(cw + 2 * 5632 + cvi), vb = *(const f32x4*)(cb + cvi);
        const int I0 = wid * 64 + i0;
        const int Ip = I0 > 0 ? I0 - 1 : 0;
        f32x4 pg = *(const f32x4*)(Tall + Ip * 68 + c4), pv = *(const f32x4*)(Tall + Ip * 68 + 32 + c4);
        f32x4 cg2 = *(const f32x4*)(Tall + I0 * 68 + c4), cv2 = *(const f32x4*)(Tall + I0 * 68 + 32 + c4);
#pragma unroll
        for (int ii = 0; ii < 8; ++ii) {
          const int I = I0 + ii;
          const int In = I < 255 ? I + 1 : 255;
          const f32x4 ng_ = *(const f32x4*)(Tall + In * 68 + c4), nv_ = *(const f32x4*)(Tall + In * 68 + 32 + c4);
          const int t = t0 + I;
          const int pos = t & sqm;
          const float mp = (pos == 0) ? 0.f : 1.f, mn = (pos == sqm) ? 0.f : 1.f;
          const f32x4 G = gb + g0 * (pg * mp) + g1 * cg2 + g2 * (ng_ * mn);
          const f32x4 V = vb + v0 * (pv * mp) + v1 * cv2 + v2 * (nv_ * mn);
          const unsigned w0 = pk2(silu_f(G[0]) * V[0], silu_f(G[1]) * V[1]), w1 = pk2(silu_f(G[2]) * V[2], silu_f(G[3]) * V[3]);
          if (I >= 1 && I <= 254 && t < slen)
            __builtin_nontemporal_store((u32x2){w0, w1}, (u32x2*)(U + (size_t)(sbase + t) * FF + cgi));
          pg = cg2; pv = cv2; cg2 = ng_; cv2 = nv_;
        }
        __syncthreads();
      }
    }
  }
}

template <int DV, bool NBM>
DI void flash_core(f32x16 (&oacc)[DV / 32], float& l_out, const bf16_t* qptr, const bf16_t* kbase, int ldk, const bf16_t* vtbase, int ldv,
                   int s0, int n0, int s1, int n1, unsigned char* smem,
                   int rq, int r0q, int r0a, const float* rpbL, int cq) {
  constexpr int NDB = DV / 32;
  constexpr int BUFB = 9216 + DV * 144;
  const int tid = get_tid(), lane = tid & 63, l31 = lane & 31, half = lane >> 5;
  const int lrow = tid >> 3, lch = tid & 7;
  bf16x8 qf[4];
#pragma unroll
  for (int ks = 0; ks < 4; ++ks) qf[ks] = *(const bf16x8*)(qptr + ks * 16 + half * 8);
  float m_run = 0.f, l_run = 0.f;
  f32x16 negm;
#pragma unroll
  for (int r = 0; r < 16; ++r) negm[r] = 0.f;
#pragma unroll
  for (int db = 0; db < NDB; ++db)
#pragma unroll
    for (int r = 0; r < 16; ++r) oacc[db][r] = 0.f;
  u32x4 rkA[2], rvA[NDB], rkB[2], rvB[NDB];
  const int ntl = n0 + n1;
  auto gload = [&](int it, u32x4 (&rk)[2], u32x4 (&rv)[NDB]) {
    const int key0 = it < n0 ? s0 + it * 64 : s1 + (it - n0) * 64;
#pragma unroll
    for (int j = 0; j < 2; ++j) rk[j] = *(const u32x4*)(kbase + (long)(key0 + lrow + 32 * j) * ldk + lch * 8);
#pragma unroll
    for (int j = 0; j < NDB; ++j) rv[j] = *(const u32x4*)(vtbase + (long)(lrow + 32 * j) * ldv + key0 + lch * 8);
  };
  auto sstore = [&](int buf, const u32x4 (&rk)[2], const u32x4 (&rv)[NDB]) {
    unsigned char* ks_ = smem + buf * BUFB;
#pragma unroll
    for (int j = 0; j < 2; ++j) *(u32x4*)(ks_ + (lrow + 32 * j) * 144 + lch * 16) = rk[j];
#pragma unroll
    for (int j = 0; j < NDB; ++j) *(u32x4*)(ks_ + 9216 + (lrow + 32 * j) * 144 + ((lch ^ ((lrow >> 3) & 3)) * 16)) = rv[j];
  };
  const int c0 = iclamp(cq - 8, 0, 48);
  const int x16 = ((l31 >> 3) & 3) << 4;
  auto compute = [&](int it) {
    bool active = true;
    int dr = 0;
    if (NBM && it >= n0) { const int rr = r0a + (it - n0); active = (rr >= r0q) && (rr < r0q + 8); dr = rr - rq + 7; }
    if (active) {
      const unsigned char* ks_ = smem + (it & 1) * BUFB;
      const unsigned char* vs_ = ks_ + 9216;
      f32x16 s[2];
#pragma unroll
      for (int kb = 0; kb < 2; ++kb) {
#pragma unroll
        for (int ks = 0; ks < 4; ++ks) {
          bf16x8 a = *(const bf16x8*)(ks_ + (kb * 32 + l31) * 144 + (ks * 16 + half * 8) * 2);
          __builtin_amdgcn_s_setprio(1);
          s[kb] = mfma32(a, qf[ks], ks == 0 ? negm : s[kb]);
          __builtin_amdgcn_s_setprio(0);
        }
      }
      if (NBM && it >= n0) {
#pragma unroll
        for (int kb = 0; kb < 2; ++kb)
#pragma unroll
          for (int r = 0; r < 16; ++r) {
            const int ck = kb * 32 + 8 * (r >> 2) + 4 * half + (r & 3);
            const bool inw = (ck >= c0) && (ck < c0 + 16);
            const int dc = iclamp(ck - cq, -15, 15) + 15;
            const float bias = rpbL[dr * 31 + dc];
            s[kb][r] = inw ? s[kb][r] + bias : -1e30f;
          }
      }
      float mx = s[0][0];
#pragma unroll
      for (int kb = 0; kb < 2; ++kb)
#pragma unroll
        for (int r = 0; r < 16; ++r) mx = fmaxf(mx, s[kb][r]);
      const bool first = (it == 0);
      if (first || __any(mx > 8.0f)) {
        mx = fmaxf(mx, shx(mx, 32, lane));
        const float delta = first ? mx : fmaxf(mx, 0.f);
        const float alpha = first ? 0.f : fexp2(-delta);
        m_run += delta;
#pragma unroll
        for (int kb = 0; kb < 2; ++kb)
#pragma unroll
          for (int r = 0; r < 16; ++r) s[kb][r] -= delta;
        l_run *= alpha;
#pragma unroll
        for (int db = 0; db < NDB; ++db)
#pragma unroll
          for (int r = 0; r < 16; ++r) oacc[db][r] *= alpha;
#pragma unroll
        for (int r = 0; r < 16; ++r) negm[r] = -m_run;
      }
      float ps = 0.f;
#pragma unroll
      for (int kb = 0; kb < 2; ++kb)
#pragma unroll
        for (int r = 0; r < 16; ++r) { const float pe = fexp2(s[kb][r]); s[kb][r] = pe; ps += pe; }
      l_run += ps;
#pragma unroll
      for (int kb = 0; kb < 2; ++kb)
#pragma unroll
        for (int j = 0; j < 2; ++j) {
          __builtin_amdgcn_sched_barrier(0);
          u32x4 pw = {pk2(s[kb][8 * j + 0], s[kb][8 * j + 1]), pk2(s[kb][8 * j + 2], s[kb][8 * j + 3]),
                      pk2(s[kb][8 * j + 4], s[kb][8 * j + 5]), pk2(s[kb][8 * j + 6], s[kb][8 * j + 7])};
          const bf16x8 pb = __builtin_bit_cast(bf16x8, pw);
#pragma unroll
          for (int db = 0; db < NDB; ++db) {
            const unsigned char* va = vs_ + (db * 32 + l31) * 144 + half * 8;
            u32x2 v0 = *(const u32x2*)(va + (((kb * 4 + j * 2) << 4) ^ x16)), v1 = *(const u32x2*)(va + (((kb * 4 + j * 2 + 1) << 4) ^ x16));
            u32x4 vw = {v0[0], v0[1], v1[0], v1[1]};
            __builtin_amdgcn_s_setprio(1);
            oacc[db] = mfma32(__builtin_bit_cast(bf16x8, vw), pb, oacc[db]);
            __builtin_amdgcn_s_setprio(0);
          }
        }
    }
  };
  gload(0, rkA, rvA); sstore(0, rkA, rvA); __syncthreads();
  if (ntl > 1) gload(1, rkA, rvA);
  for (int it = 0; it < ntl; it += 2) {
    if (it + 2 < ntl) gload(it + 2, rkB, rvB);
    compute(it);
    if (it + 1 < ntl) sstore((it + 1) & 1, rkA, rvA);
    __syncthreads();
    if (it + 1 < ntl) {
      if (it + 3 < ntl) gload(it + 3, rkA, rvA);
      compute(it + 1);
      if (it + 2 < ntl) sstore((it + 2) & 1, rkB, rvB);
      __syncthreads();
    }
  }
  l_out = l_run + shx(l_run, 32, lane);
}


DI void flash_core_q64(f32x16 (&oacc)[2][2], float (&l_out)[2], const bf16_t* qptr0, const bf16_t* qptr1, const bf16_t* kbase, int ldk,
                       const bf16_t* vtbase, int ldv, int ntl, unsigned char* smem) {
  constexpr int BUFB = 9216 + 64 * 144;
  const int tid = get_tid(), lane = tid & 63, l31 = lane & 31, half = lane >> 5;
  const int lrow = tid >> 3, lch = tid & 7;
  bf16x8 qf[2][4];
#pragma unroll
  for (int ks = 0; ks < 4; ++ks) { qf[0][ks] = *(const bf16x8*)(qptr0 + ks * 16 + half * 8); qf[1][ks] = *(const bf16x8*)(qptr1 + ks * 16 + half * 8); }
  float m_run[2] = {0.f, 0.f}, l_run[2] = {0.f, 0.f};
#pragma unroll
  for (int qb = 0; qb < 2; ++qb)
#pragma unroll
    for (int db = 0; db < 2; ++db)
#pragma unroll
      for (int r = 0; r < 16; ++r) oacc[qb][db][r] = 0.f;
  u32x4 rk[2], rv[2];
  auto gload = [&](int it) {
    const int key0 = it * 64;
#pragma unroll
    for (int j = 0; j < 2; ++j) rk[j] = *(const u32x4*)(kbase + (long)(key0 + lrow + 32 * j) * ldk + lch * 8);
#pragma unroll
    for (int j = 0; j < 2; ++j) rv[j] = *(const u32x4*)(vtbase + (long)(lrow + 32 * j) * ldv + key0 + lch * 8);
  };
  auto sstore = [&](int buf) {
    unsigned char* ks_ = smem + buf * BUFB;
#pragma unroll
    for (int j = 0; j < 2; ++j) *(u32x4*)(ks_ + (lrow + 32 * j) * 144 + lch * 16) = rk[j];
#pragma unroll
    for (int j = 0; j < 2; ++j) *(u32x4*)(ks_ + 9216 + (lrow + 32 * j) * 144 + ((lch ^ ((lrow >> 3) & 3)) * 16)) = rv[j];
  };
  const int x16 = ((l31 >> 3) & 3) << 4;
  gload(0); sstore(0); __syncthreads();
  for (int it = 0; it < ntl; ++it) {
    if (it + 1 < ntl) gload(it + 1);
    {
      const unsigned char* ks_ = smem + (it & 1) * BUFB;
      const unsigned char* vs_ = ks_ + 9216;
      f32x16 s[2][2];
      __builtin_amdgcn_s_setprio(1);
#pragma unroll
      for (int kb = 0; kb < 2; ++kb)
#pragma unroll
        for (int ks = 0; ks < 4; ++ks) {
          bf16x8 a = *(const bf16x8*)(ks_ + (kb * 32 + l31) * 144 + (ks * 16 + half * 8) * 2);
#pragma unroll
          for (int qb = 0; qb < 2; ++qb) {
            if (ks == 0) {
#pragma unroll
              for (int r = 0; r < 16; ++r) s[qb][kb][r] = -m_run[qb];
            }
            s[qb][kb] = mfma32(a, qf[qb][ks], s[qb][kb]);
          }
        }
      __builtin_amdgcn_s_setprio(0);
      const bool first = (it == 0);
#pragma unroll
      for (int qb = 0; qb < 2; ++qb) {
        float mx = s[qb][0][0];
#pragma unroll
        for (int kb = 0; kb < 2; ++kb)
#pragma unroll
          for (int r = 0; r < 16; ++r) mx = fmaxf(mx, s[qb][kb][r]);
        if (first || __any(mx > 8.0f)) {
          mx = fmaxf(mx, shx(mx, 32, lane));
          const float delta = first ? mx : fmaxf(mx, 0.f);
          const float alpha = first ? 0.f : fexp2(-delta);
          m_run[qb] += delta;
#pragma unroll
          for (int kb = 0; kb < 2; ++kb)
#pragma unroll
            for (int r = 0; r < 16; ++r) s[qb][kb][r] -= delta;
          l_run[qb] *= alpha;
#pragma unroll
          for (int db = 0; db < 2; ++db)
#pragma unroll
            for (int r = 0; r < 16; ++r) oacc[qb][db][r] *= alpha;
        }
        float ps = 0.f;
#pragma unroll
        for (int kb = 0; kb < 2; ++kb)
#pragma unroll
          for (int r = 0; r < 16; ++r) { const float pe = fexp2(s[qb][kb][r]); s[qb][kb][r] = pe; ps += pe; }
        l_run[qb] += ps;
      }
#pragma unroll
      for (int kb = 0; kb < 2; ++kb)
#pragma unroll
        for (int j = 0; j < 2; ++j) {
          __builtin_amdgcn_sched_barrier(0);
          bf16x8 pb[2];
#pragma unroll
          for (int qb = 0; qb < 2; ++qb) {
            u32x4 pw = {pk2(s[qb][kb][8 * j + 0], s[qb][kb][8 * j + 1]), pk2(s[qb][kb][8 * j + 2], s[qb][kb][8 * j + 3]),
                        pk2(s[qb][kb][8 * j + 4], s[qb][kb][8 * j + 5]), pk2(s[qb][kb][8 * j + 6], s[qb][kb][8 * j + 7])};
            pb[qb] = __builtin_bit_cast(bf16x8, pw);
          }
#pragma unroll
          for (int db = 0; db < 2; ++db) {
            const unsigned char* va = vs_ + (db * 32 + l31) * 144 + half * 8;
            u32x2 v0 = *(const u32x2*)(va + (((kb * 4 + j * 2) << 4) ^ x16)), v1 = *(const u32x2*)(va + (((kb * 4 + j * 2 + 1) << 4) ^ x16));
            u32x4 vw = {v0[0], v0[1], v1[0], v1[1]};
            const bf16x8 vf = __builtin_bit_cast(bf16x8, vw);
            __builtin_amdgcn_s_setprio(1);
            oacc[0][db] = mfma32(vf, pb[0], oacc[0][db]);
            oacc[1][db] = mfma32(vf, pb[1], oacc[1][db]);
            __builtin_amdgcn_s_setprio(0);
          }
        }
    }
    if (it + 1 < ntl) sstore((it + 1) & 1);
    __syncthreads();
  }
  l_out[0] = l_run[0] + shx(l_run[0], 32, lane);
  l_out[1] = l_run[1] + shx(l_run[1], 32, lane);
}

template <int NDB>
DI void store_o(const f32x16 (&o)[NDB], bf16_t* orow, int half) {
#pragma unroll
  for (int db = 0; db < NDB; ++db)
#pragma unroll
    for (int g = 0; g < 4; ++g)
      *(u32x2*)(orow + db * 32 + 8 * g + 4 * half) = (u32x2){pk2(o[db][4 * g], o[db][4 * g + 1]), pk2(o[db][4 * g + 2], o[db][4 * g + 3])};
}

DI void attn_a_phase(const Params& p, unsigned char* smem) {
  const int tid = get_tid(), lane = tid & 63, wid = tid >> 6, l31 = lane & 31, half = lane >> 5;
  const bf16_t* Qb = (const bf16_t*)(p.ws + OFF_QKV);
  const bf16_t* Kb = Qb + (size_t)MTOT * 1024;
  const bf16_t* VTb = Kb + (size_t)MTOT * 256;
  bf16_t* O = (bf16_t*)(p.ws + OFF_H);
  const int nitems = NB * 4 * 9 * 4;
  for (int item = get_bid(); item < nitems; item += gridDim.x) {
    const int g = item & 3, qb = (item >> 2) % 9, bk = item / 36, kvh = bk & 3, b = bk >> 2;
    const int qh = kvh * 4 + g;
    int qP, nt, orow0;
    if (qb < 8) { qP = b * TP + CL + qb * 256; nt = 36; orow0 = b * TL + qb * 256; }
    else { qP = b * TP; nt = 4; orow0 = MLAT + b * CL; }
    f32x16 oacc[2][2]; float l[2];
    const bf16_t* q0 = Qb + (size_t)(qP + wid * 64 + l31) * 1024 + qh * 64;
    flash_core_q64(oacc, l, q0, q0 + 32 * 1024, Kb + (size_t)b * TP * 256 + kvh * 64, 256, VTb + (size_t)(b * 256 + kvh * 64) * TP, TP, nt, smem);
#pragma unroll
    for (int qq = 0; qq < 2; ++qq) {
      const float inv = 1.0f / l[qq];
#pragma unroll
      for (int db = 0; db < 2; ++db)
#pragma unroll
        for (int r = 0; r < 16; ++r) oacc[qq][db][r] *= inv;
      store_o<2>(oacc[qq], O + (size_t)(orow0 + wid * 64 + qq * 32 + l31) * 1024 + qh * 64, half);
    }
  }
}

DI void attn_b_phase(const Params& p, unsigned char* smem) {
  const int tid = get_tid(), lane = tid & 63, wid = tid >> 6, l31 = lane & 31, half = lane >> 5;
  const bf16_t* Qb = (const bf16_t*)(p.ws + OFF_QKV);
  const bf16_t* Kb = Qb + (size_t)MTOT * 1024;
  const bf16_t* VTb = Kb + (size_t)MTOT * 1024;
  bf16_t* O = (bf16_t*)(p.ws + OFF_H);
  float d1 = 0.f, d2 = 0.f;
  for (int e = 0; e < 64; ++e) { d1 += p.in[I_BLQ1][e] * p.in[I_BLK1][e]; d2 += p.in[I_BLQ2][e] * p.in[I_BLK2][e]; }
  const float lam = __expf(d1) - __expf(d2) + LAM_INIT_B;
  const float* subln = p.in[I_BSUB];
  const int nitems = NB * 8 * 18;
  for (int item = get_bid(); item < nitems; item += gridDim.x) {
    const int qb = item % 18, h = (item / 18) & 7, b = item / 144;
    int qP, nt, orow0;
    if (qb < 16) { qP = b * TP + CL + qb * 128; nt = 36; orow0 = b * TL + qb * 128; }
    else { qP = b * TP + (qb - 16) * 128; nt = 4; orow0 = MLAT + b * CL + (qb - 16) * 128; }
    bf16_t* orow = O + (size_t)(orow0 + wid * 32 + l31) * 1024 + h * 128;
    const bf16_t* vt = VTb + (size_t)(b * 1024 + h * 128) * TP;
    f32x16 oacc[4]; float l;
    flash_core<128, false>(oacc, l, Qb + (size_t)(qP + wid * 32 + l31) * 1024 + h * 128, Kb + (size_t)b * TP * 1024 + h * 128, 1024,
                           vt, TP, 0, nt, 0, 0, smem, 0, 0, 0, nullptr, 0);
    {
      const float inv = 1.0f / l;
#pragma unroll
      for (int db = 0; db < 4; ++db)
#pragma unroll
        for (int r = 0; r < 16; ++r) oacc[db][r] *= inv;
      store_o<4>(oacc, orow, half);
    }
    flash_core<128, false>(oacc, l, Qb + (size_t)(qP + wid * 32 + l31) * 1024 + h * 128 + 64, Kb + (size_t)b * TP * 1024 + h * 128 + 64, 1024,
                           vt, TP, 0, nt, 0, 0, smem, 0, 0, 0, nullptr, 0);
    {
      const float inv = lam / l;
      float ss = 0.f;
#pragma unroll
      for (int db = 0; db < 4; ++db)
#pragma unroll
        for (int g = 0; g < 4; ++g) {
          u32x2 o1 = *(const u32x2*)(orow + db * 32 + 8 * g + 4 * half);
          const float a0 = bflo(o1[0]), a1 = bfhi(o1[0]), a2 = bflo(o1[1]), a3 = bfhi(o1[1]);
          float v0 = a0 - oacc[db][4 * g] * inv, v1 = a1 - oacc[db][4 * g + 1] * inv, v2 = a2 - oacc[db][4 * g + 2] * inv, v3 = a3 - oacc[db][4 * g + 3] * inv;
          oacc[db][4 * g] = v0; oacc[db][4 * g + 1] = v1; oacc[db][4 * g + 2] = v2; oacc[db][4 * g + 3] = v3;
          ss += (v0 * v0 + v1 * v1) + (v2 * v2 + v3 * v3);
        }
      ss += shx(ss, 32, lane);
      const float rinv = rsqrtf(ss * (1.0f / 128.0f) + 1e-6f) * (1.0f - LAM_INIT_B);
#pragma unroll
      for (int db = 0; db < 4; ++db)
#pragma unroll
        for (int g = 0; g < 4; ++g) {
          f32x4 sg = *(const f32x4*)(subln + db * 32 + 8 * g + 4 * half);
#pragma unroll
          for (int e = 0; e < 4; ++e) oacc[db][4 * g + e] *= rinv * sg[e];
        }
      store_o<4>(oacc, orow, half);
    }
  }
}

DI void attn_d_phase(const Params& p, unsigned char* smem) {
  const int tid = get_tid(), lane = tid & 63, wid = tid >> 6, l31 = lane & 31, half = lane >> 5;
  const bf16_t* Qb = (const bf16_t*)(p.ws + OFF_QKV);
  const bf16_t* Kb = Qb + (size_t)MTOT * 1024;
  const bf16_t* VTb = Kb + (size_t)MTOT * 1024;
  bf16_t* O = (bf16_t*)(p.ws + OFF_H);
  float* rpbL = (float*)(smem + 57344);
  const int nitems = NB * 16 * 16;
  for (int item = get_bid(); item < nitems; item += gridDim.x) {
    const int rp = item & 15, h = (item >> 4) & 15, b = item >> 8;
    const int ra = 2 * rp, rb = 2 * rp + 1;
    const int r0a = iclamp(ra - 4, 0, 24), r0b = iclamp(rb - 4, 0, 24);
    const int rq = wid < 2 ? ra : rb, r0q = wid < 2 ? r0a : r0b;
    const int nband = r0b + 8 - r0a;
    for (int e = tid; e < 465; e += NTHREADS) rpbL[e] = p.in[I_DRPB][h * 465 + e] * LOG2E;
    const int qP = b * TP + CL + rp * 128, orow0 = b * TL + rp * 128;
    f32x16 oacc[2]; float l;
    flash_core<64, true>(oacc, l, Qb + (size_t)(qP + wid * 32 + l31) * 1024 + h * 64, Kb + (size_t)b * TP * 1024 + h * 64, 1024,
                         VTb + (size_t)(b * 1024 + h * 64) * TP, TP, 0, 4, CL + r0a * 64, nband, smem, rq, r0q, r0a, rpbL, (wid & 1) * 32 + l31);
    const float inv = 1.0f / l;
#pragma unroll
    for (int db = 0; db < 2; ++db)
#pragma unroll
      for (int r = 0; r < 16; ++r) oacc[db][r] *= inv;
    store_o<2>(oacc, O + (size_t)(orow0 + wid * 32 + l31) * 1024 + h * 64, half);
  }
}

DI void gla_scan_phase(const Params& p, unsigned char* smem) {
  const int tid0 = get_tid();
  const bf16_t* Qb = (const bf16_t*)(p.ws + OFF_QKV);
  const bf16_t* Kb = Qb + (size_t)MTOT * 512;
  const bf16_t* VTb = Kb + (size_t)MTOT * 512;
  const float* ZB = (const float*)(p.ws + OFF_ZB);
  unsigned char* qs = smem;
  unsigned char* ks = smem + 17408;
  unsigned char* kT = smem + 34816;
  unsigned char* vs = smem + 53248;
  float* zs = (float*)(smem + 71680);
  float* gs = (float*)(smem + 75776);
  float* eb = (float*)(smem + 76800);
  unsigned char* As = smem;
  for (int item = get_bid(); item < 512; item += gridDim.x) {
    const int vsl = item & 1, dir = (item >> 1) & 1, h = (item >> 2) & 3, b = item >> 4;
    const float* wg0 = (dir ? p.in[I_CGB] : p.in[I_CGF]) + h * 128;
    const float* gbp0 = (dir ? p.in[I_CBB] : p.in[I_CBF]) + h * 128;
    bf16_t* OUT = (bf16_t*)(p.ws + (dir ? OFF_Y : OFF_H));
    const size_t bP = (size_t)b * TP;
    f32x16 sacc[4];
#pragma unroll
    for (int kb = 0; kb < 4; ++kb)
#pragma unroll
      for (int r = 0; r < 16; ++r) sacc[kb][r] = 0.f;
    f32x4 pz; u32x4 pq[4], pk[4], pv[4];
    float wgt[16];
    { const int d0 = tid0 & 127;
#pragma unroll
      for (int r = 0; r < 16; ++r) wgt[r] = wg0[r * 512 + d0]; }
    const float gbias = gbp0[tid0 & 127];
    for (int c = 0; c < 36; ++c) {
      int base, sgn;
      if (!dir) { base = 64 * c; sgn = 1; } else { base = (c < 4) ? 255 - 64 * c : 2303 - 64 * (c - 4); sgn = -1; }
      const int tid = launder(tid0), lane = tid & 63, w = tid >> 6, l31 = lane & 31, half = lane >> 5, d = tid & 127, tg = tid >> 7;
#define GLA_FETCH(cc) { \
        int base_, sgn_; \
        if (!dir) { base_ = 64 * (cc); sgn_ = 1; } else { base_ = ((cc) < 4) ? 255 - 64 * (cc) : 2303 - 64 * ((cc) - 4); sgn_ = -1; } \
        { const int pp = tid >> 2, r4 = tid & 3; pz = *(const f32x4*)(ZB + (bP + base_ + sgn_ * pp) * 32 + dir * 16 + r4 * 4); } \
        _Pragma("unroll") for (int j = 0; j < 4; ++j) { \
          const int idx = tid + 256 * j, pp = idx >> 4, ch = idx & 15; \
          const size_t row = bP + base_ + sgn_ * pp; \
          pq[j] = *(const u32x4*)(Qb + row * 512 + h * 128 + ch * 8); \
          pk[j] = *(const u32x4*)(Kb + row * 512 + h * 128 + ch * 8); } \
        _Pragma("unroll") for (int j = 0; j < 4; ++j) { \
          const int idx = tid + 256 * j, row = idx >> 3, ch = idx & 7; \
          const bf16_t* src = VTb + ((size_t)(b * 1024 + h * 256 + vsl * 128 + row)) * TP; \
          pv[j] = (!dir) ? *(const u32x4*)(src + base_ + ch * 8) : *(const u32x4*)(src + base_ - 8 * ch - 7); } }
      if (c == 0) GLA_FETCH(0);
      { const int pp = tid >> 2, r4 = tid & 3; *(f32x4*)(zs + pp * 16 + r4 * 4) = pz; }
#pragma unroll
      for (int j = 0; j < 4; ++j) {
        const int idx = tid + 256 * j, pp = idx >> 4, ch = idx & 15;
        *(u32x4*)(qs + pp * 272 + ch * 16) = pq[j];
        *(u32x4*)(ks + pp * 272 + ch * 16) = pk[j];
      }
#pragma unroll
      for (int j = 0; j < 4; ++j) {
        const int idx = tid + 256 * j, row = idx >> 3, ch = idx & 7;
        u32x4 t = pv[j];
        u32x4 v = (!dir) ? t : (u32x4){(t[3] >> 16) | (t[3] << 16), (t[2] >> 16) | (t[2] << 16), (t[1] >> 16) | (t[1] << 16), (t[0] >> 16) | (t[0] << 16)};
        *(u32x4*)(vs + row * 144 + ch * 16) = v;
      }
      if (c + 1 < 36) GLA_FETCH(c + 1);
#undef GLA_FETCH
      __syncthreads();
      {
        float g[32];
        float tot = 0.f;
#pragma unroll
        for (int pp = 0; pp < 32; ++pp) {
          const float* z = zs + (tg * 32 + pp) * 16;
          float a = gbias;
#pragma unroll
          for (int r4 = 0; r4 < 4; ++r4) {
            f32x4 zv = *(const f32x4*)(z + r4 * 4);
            a += zv[0] * wgt[r4 * 4] + zv[1] * wgt[r4 * 4 + 1] + zv[2] * wgt[r4 * 4 + 2] + zv[3] * wgt[r4 * 4 + 3];
          }
          const float ls = fminf(a, 0.f) - __logf(1.0f + __expf(-fabsf(a)));
          g[pp] = ls * (1.0f / 16.0f);
          tot += g[pp];
        }
        gs[tg * 128 + d] = tot;
        __syncthreads();
        const float t0 = gs[d], t1 = gs[128 + d];
        const float blast = t0 + t1;
        const float eblast = __expf(blast);
        if (tg == 0) eb[d] = eblast;
        float run = tg ? t0 : 0.f;
#pragma unroll
        for (int pp = 0; pp < 32; pp += 2) {
          unsigned kTw = 0;
#pragma unroll
          for (int e = 0; e < 2; ++e) {
            const int tp = tg * 32 + pp + e;
            run += g[pp + e];
            const float eq = __expf(run), eki = __expf(-run);
            bf16_t* qa = (bf16_t*)(qs + tp * 272 + d * 2);
            bf16_t* ka = (bf16_t*)(ks + tp * 272 + d * 2);
            const float qv = bf2f(*qa), kv = bf2f(*ka);
            *qa = (bf16_t)(pk2(qv * eq, 0.f) & 0xffffu);
            *ka = (bf16_t)(pk2(kv * eki, 0.f) & 0xffffu);
            const unsigned kt = pk2(kv * eki * eblast, 0.f) & 0xffffu;
            kTw |= kt << (16 * e);
          }
          *(unsigned*)(kT + d * 144 + (tg * 32 + pp) * 2) = kTw;
        }
      }
      __syncthreads();
      __builtin_amdgcn_sched_barrier(0);
      f32x16 aacc, oacc[2];
#pragma unroll
      for (int r = 0; r < 16; ++r) { aacc[r] = 0.f; oacc[0][r] = 0.f; oacc[1][r] = 0.f; }
      const int bi = w >> 1, bj = w & 1;
      if (w != 1) {
#pragma unroll
        for (int k8 = 0; k8 < 8; ++k8) {
          bf16x8 a = *(const bf16x8*)(qs + (32 * bi + l31) * 272 + (16 * k8 + 8 * half) * 2);
          bf16x8 bb = *(const bf16x8*)(ks + (32 * bj + l31) * 272 + (16 * k8 + 8 * half) * 2);
          aacc = mfma32(a, bb, aacc);
        }
#pragma unroll
        for (int r = 0; r < 16; ++r) {
          const int i = 32 * bi + 8 * (r >> 2) + 4 * half + (r & 3), jx = 32 * bj + l31;
          aacc[r] = (jx <= i) ? aacc[r] : 0.f;
        }
      }
#pragma unroll
      for (int kb = 0; kb < 4; ++kb)
#pragma unroll
        for (int j = 0; j < 2; ++j) {
          __builtin_amdgcn_sched_barrier(0);
          u32x4 sw = {pk2(sacc[kb][8 * j + 0], sacc[kb][8 * j + 1]), pk2(sacc[kb][8 * j + 2], sacc[kb][8 * j + 3]),
                      pk2(sacc[kb][8 * j + 4], sacc[kb][8 * j + 5]), pk2(sacc[kb][8 * j + 6], sacc[kb][8 * j + 7])};
          const bf16x8 sb = __builtin_bit_cast(bf16x8, sw);
#pragma unroll
          for (int tb = 0; tb < 2; ++tb) {
            const unsigned char* qa = qs + (32 * tb + l31) * 272 + (32 * kb + 16 * j + 4 * half) * 2;
            u32x2 q0 = *(const u32x2*)(qa), q1 = *(const u32x2*)(qa + 16);
            u32x4 qw = {q0[0], q0[1], q1[0], q1[1]};
            oacc[tb] = mfma32(__builtin_bit_cast(bf16x8, qw), sb, oacc[tb]);
          }
        }
      __syncthreads();
#pragma unroll
      for (int r = 0; r < 16; ++r) {
        const int i = 32 * bi + 8 * (r >> 2) + 4 * half + (r & 3), jx = 32 * bj + l31;
        *(bf16_t*)(As + i * 144 + jx * 2) = (bf16_t)(pk2(aacc[r], 0.f) & 0xffffu);
      }
      __syncthreads();
      __builtin_amdgcn_sched_barrier(0);
      bf16x8 vfr[4];
#pragma unroll
      for (int k4 = 0; k4 < 4; ++k4) vfr[k4] = *(const bf16x8*)(vs + (32 * w + l31) * 144 + (16 * k4 + 8 * half) * 2);
#pragma unroll
      for (int tb = 0; tb < 2; ++tb)
#pragma unroll
        for (int k4 = 0; k4 < 4; ++k4) {
          bf16x8 a = *(const bf16x8*)(As + (32 * tb + l31) * 144 + (16 * k4 + 8 * half) * 2);
          oacc[tb] = mfma32(a, vfr[k4], oacc[tb]);
        }
#pragma unroll
      for (int tb = 0; tb < 2; ++tb)
#pragma unroll
        for (int r = 0; r < 16; ++r) {
          const int tp = 32 * tb + 8 * (r >> 2) + 4 * half + (r & 3);
          const int kidx = base + sgn * tp;
          const int urow = kidx < CL ? MLAT + b * CL + kidx : b * TL + kidx - CL;
          OUT[(size_t)urow * 1024 + h * 256 + vsl * 128 + 32 * w + l31] = (bf16_t)(pk2(oacc[tb][r], 0.f) & 0xffffu);
        }
#pragma unroll
      for (int kb = 0; kb < 4; ++kb) {
        __builtin_amdgcn_sched_barrier(0);
#pragma unroll
        for (int g4 = 0; g4 < 4; ++g4) {
          f32x4 e4 = *(const f32x4*)(eb + 32 * kb + 8 * g4 + 4 * half);
#pragma unroll
          for (int e = 0; e < 4; ++e) sacc[kb][4 * g4 + e] *= e4[e];
        }
#pragma unroll
        for (int k4 = 0; k4 < 4; ++k4) {
          bf16x8 a = *(const bf16x8*)(kT + (32 * kb + l31) * 144 + (16 * k4 + 8 * half) * 2);
          sacc[kb] = mfma32(a, vfr[k4], sacc[kb]);
        }
      }
      __syncthreads();
    }
  }
}


#define XB_TMO      128
#define XB_XCNT(j)  (256  + 64 * (j))
#define XB_XSUB(j)  (1280 + 64 * (j))
#define XB_XGEN(j)  (2304 + 64 * (j))
#define XB_TOP      3328
#define XB_TOPGEN   3392
#define XCD_BAR_WORDS 3456
#define XB_SPIN_CAP (1u << 20)
#define LAS __attribute__((address_space(3)))
DI unsigned xb_ld(unsigned* p) { return __hip_atomic_load(p, __ATOMIC_RELAXED, __HIP_MEMORY_SCOPE_AGENT); }
DI unsigned xb_add(unsigned* p, unsigned v) { return __hip_atomic_fetch_add(p, v, __ATOMIC_RELAXED, __HIP_MEMORY_SCOPE_AGENT); }
DI unsigned xb_xcc_id() { return (unsigned)__builtin_amdgcn_s_getreg((3 << 11) | 20) & 0xFu; }
#define XB_SPIN(cond, bar) do { unsigned _sp = 0; while (cond) { __builtin_amdgcn_s_sleep(1); \
    if ((++_sp & 255u) == 0u) { if (xb_ld(&(bar)[XB_TMO])) break; if (_sp > XB_SPIN_CAP) { atomicAdd(&(bar)[XB_TMO], 1u); break; } } } } while (0)
struct XcdBarrier { unsigned* bar; unsigned x; volatile LAS unsigned* st; };
DI XcdBarrier xcd_barrier_post(unsigned* bar, volatile LAS unsigned* st) {
  XcdBarrier b; b.bar = bar; b.x = xb_xcc_id(); b.st = st;
  if (threadIdx.x == 0) (void)xb_add(&bar[XB_XCNT(b.x)], 1u);
  return b;
}
DI void xcd_barrier_complete(unsigned* bar, unsigned x, unsigned& nloc, unsigned& nx) {
  const unsigned G = gridDim.x * gridDim.y * gridDim.z;
  unsigned sum, cnt, mine, sp = 0u;
  for (;;) {
    sum = 0u; cnt = 0u; mine = 0u;
#pragma unroll
    for (unsigned j = 0; j < 16; ++j) { const unsigned c = xb_ld(&bar[XB_XCNT(j)]); sum += c; cnt += (c > 0u) ? 1u : 0u; mine = (j == x) ? c : mine; }
    if (sum == G) break;
    __builtin_amdgcn_s_sleep(1);
    if ((++sp & 255u) == 0u) { if (xb_ld(&bar[XB_TMO])) break; if (sp > XB_SPIN_CAP) { atomicAdd(&bar[XB_TMO], 1u); break; } }
  }
  nloc = mine > 0u ? mine : 1u; nx = cnt > 0u ? cnt : 1u;
}
DI void xcd_barrier(unsigned char* ws, volatile LAS unsigned* st_) {
  XcdBarrier b; b.bar = (unsigned*)(ws + OFF_BAR); b.x = xb_xcc_id(); b.st = st_;
  asm volatile("s_waitcnt vmcnt(0)" ::: "memory");
  __syncthreads();
  if (threadIdx.x == 0) {
    unsigned* bar = b.bar;
    __builtin_amdgcn_s_waitcnt(0);
    unsigned nloc = b.st[0], nx = b.st[1];
    if (nloc == 0u) { xcd_barrier_complete(bar, b.x, nloc, nx); b.st[0] = nloc; b.st[1] = nx; }
    const unsigned old = xb_add(&bar[XB_XSUB(b.x)], 1u);
    const unsigned gen = old / nloc;
    if (old + 1u == (gen + 1u) * nloc) {
      __builtin_amdgcn_fence(__ATOMIC_RELEASE, "agent");
      asm volatile("s_waitcnt vmcnt(0)" ::: "memory");
      const unsigned og = xb_add(&bar[XB_TOP], 1u);
      const unsigned tg = og / nx;
      if (og + 1u == (tg + 1u) * nx) xb_add(&bar[XB_TOPGEN], 1u);
      else XB_SPIN(xb_ld(&bar[XB_TOPGEN]) == tg, bar);
      __builtin_amdgcn_fence(__ATOMIC_ACQUIRE, "agent");
      xb_add(&bar[XB_XGEN(b.x)], 1u);
      asm volatile("s_waitcnt vmcnt(0)" ::: "memory");
    } else {
      XB_SPIN(xb_ld(&bar[XB_XGEN(b.x)]) == gen, bar);
      __builtin_amdgcn_fence(__ATOMIC_ACQUIRE, "agent");
      asm volatile("s_waitcnt vmcnt(0)" ::: "memory");
    }
  }
  __syncthreads();
}

__global__ void __launch_bounds__(NTHREADS, 2) fwd_megakernel(Params p, int ph_lo, int ph_hi) {
  __shared__ __attribute__((aligned(16))) unsigned char smem[SMEM_BYTES];
  __shared__ uint4 xb_words;
  cg::grid_group grid = cg::this_grid();
  if (threadIdx.x == 0) xb_words = make_uint4(0u, 0u, 0u, 0u);
  __syncthreads();
  (void)xcd_barrier_post((unsigned*)(p.ws + OFF_BAR), (volatile LAS unsigned*)&xb_words);
  {
    const int nmod = 384, ntr = p.wtile0[16];
    for (int it = get_bid(); it < nmod + 1 + ntr; it += gridDim.x) {
      if (it < nmod) mod_item(p, it, smem);
      else if (it == nmod) rope_item(p);
      else transpose_item(p, it - nmod - 1, smem);
    }
    grid.sync();
  }
  for (int step = ph_lo + 1; step < ph_hi; ++step) {
    int kind, layer;
    if (step < 2) { kind = step; layer = 0; } else { layer = (step - 2) >> 3; kind = 2 + ((step - 2) & 7); }
    if (kind == 4 && layer != 2) continue;
    const bool last = layer == 3;
    const bf16_t* WT = (const bf16_t*)(p.ws + OFF_WT);
    const float* MOD = (const float*)(p.ws + OFF_MOD);
    float* XC = (float*)(p.ws + OFF_XC);
    const float* modl = MOD + (size_t)layer * 33 * 6144;
    const int nrows = last ? MLAT : MTOT;
    if (kind == 0) {
    } else if (kind == 1) {
      modulate_phase(p);
    } else if (kind == 2) {
      QkvCfg cfg;
      if (layer == 0) cfg = {0, 1024, 256, 256, 12, 0.125f * LOG2E};
      else if (layer == 1) cfg = {1, 1024, 1024, 1024, 24, 0.125f * LOG2E};
      else if (layer == 2) cfg = {2, 512, 512, 1024, 25, 0.08838834764831845f};
      else cfg = {3, 1024, 1024, 1024, 24, 0.125f * LOG2E};
      gemm_qkv_phase(p, cfg, WT + p.wdst[layer * 4 + 0], p.in[I_AQN], p.in[I_AKN], smem);
    } else if (kind == 3) {
      if (layer == 0) attn_a_phase(p, smem);
      else if (layer == 1) attn_b_phase(p, smem);
      else if (layer == 2) gla_scan_phase(p, smem);
      else attn_d_phase(p, smem);
    } else if (kind == 4) {
      gla_finish_phase(p);
    } else if (kind == 5 || kind == 8) {
      const bool dn = kind == 8;
      gemm_plain_phase(p, dn ? (const bf16_t*)(p.ws + OFF_QKV) : (const bf16_t*)(p.ws + OFF_H), dn ? FF : 1024,
                       WT + p.wdst[layer * 4 + (dn ? 3 : 1)], (bf16_t*)(p.ws + OFF_Y), nrows / 256, smem);
    } else if (kind == 6 || kind == 9) {
      const bool second = kind == 9;
      const bool first_in = (!second) && layer == 0;
      ln_phase(p, first_in ? p.in[I_X] : p.out, first_in ? p.in[I_CTX] : XC, p.out, XC, modl, second ? 5 : 2,
               (second ? p.in[I_LN2G] : p.in[I_LN1G]) + layer * 1024, (second ? p.in[I_LN2B] : p.in[I_LN1B]) + layer * 1024,
               second ? modl + (size_t)33 * 6144 : modl, second ? 0 : 3, second ? 1 : 4, nrows, second ? !last : true);
    } else {
      gemm_ffn_up_phase(p, layer, WT + p.wdst[layer * 4 + 2], !last, smem);
    }
    if (step + 1 < ph_hi) {
      xcd_barrier(p.ws, (volatile LAS unsigned*)&xb_words);
    }
  }
}

extern "C" void kernel_launch(void* const* d_in, const int* in_sizes, int n_in, void* d_out, int out_size, void* d_ws, size_t ws_size,
                              hipStream_t stream) {
  static int grid_blocks = 0;
  if (!grid_blocks) {
    int dev = 0, cus = 0, per_cu = 0;
    hipGetDevice(&dev);
    hipDeviceGetAttribute(&cus, hipDeviceAttributeMultiprocessorCount, dev);
    hipOccupancyMaxActiveBlocksPerMultiprocessor(&per_cu, fwd_megakernel, NTHREADS, 0);
    if (per_cu > 2) per_cu = 2;
    grid_blocks = cus * per_cu;
    if (ws_size < WS_NEED) fprintf(stderr, "workspace too small: %zu < %zu\n", ws_size, (size_t)WS_NEED);
  }
  Params p;
  memset(&p, 0, sizeof(p));
  for (int i = 0; i < 35; ++i) p.in[i] = (const float*)d_in[i];
  p.out = (float*)d_out;
  p.ws = (unsigned char*)d_ws;
  const int qkvN[4] = {1536, 3072, 3104, 3072}, qkvNp[4] = {1536, 3072, 3200, 3072};
  const int qkvI[4] = {I_AQKV, I_BQKV, I_CWIN, I_DQKV}, woI[4] = {I_AWO, I_BWO, I_CWO, I_DWO};
  long off = 0; int t0 = 0;
  for (int l = 0; l < 4; ++l) {
    for (int k = 0; k < 4; ++k) {
      const int mi = l * 4 + k;
      int K, N, Np, mode = 0; const float* src;
      if (k == 0) { K = 1024; N = qkvN[l]; Np = qkvNp[l]; src = (const float*)d_in[qkvI[l]]; }
      else if (k == 1) { K = 1024; N = 1024; Np = 1024; src = (const float*)d_in[woI[l]]; }
      else if (k == 2) { K = 1024; N = 5632; Np = 5632; mode = 1; src = (const float*)d_in[I_UPW] + (size_t)l * 1024 * 5632; }
      else { K = 2816; N = 1024; Np = 1024; src = (const float*)d_in[I_DOWNW] + (size_t)l * 2816 * 1024; }
      p.wsrc[mi] = src; p.wdst[mi] = off; p.wK[mi] = K; p.wN[mi] = N; p.wNpad[mi] = Np; p.wmode[mi] = mode; p.wtile0[mi] = t0;
      off += (long)Np * K; t0 += (K / 64) * (Np / 64);
    }
  }
  p.wtile0[16] = t0;
  int lo = 0, hi = 34;
  hipMemsetAsync((unsigned char*)d_ws + OFF_BAR, 0, XCD_BAR_WORDS * sizeof(unsigned), stream);
  void* args[] = {&p, &lo, &hi};
  hipError_t e = hipLaunchCooperativeKernel((void*)fwd_megakernel, dim3(grid_blocks), dim3(NTHREADS), args, 0, stream);
  if (e != hipSuccess) fprintf(stderr, "cooperative launch failed: %s (grid %d)\n", hipGetErrorString(e), grid_blocks);
}
```

```cpp
#include <hip/hip_runtime.h>
#include <hip/hip_cooperative_groups.h>
#include <cstdio>
#include <cstdint>
#include <cstring>
namespace cg = cooperative_groups;

typedef unsigned short bf16_t;
typedef short bf16x8 __attribute__((ext_vector_type(8)));
typedef float f32x2 __attribute__((ext_vector_type(2)));
typedef float f32x4 __attribute__((ext_vector_type(4)));
typedef float f32x16 __attribute__((ext_vector_type(16)));
typedef unsigned u32x4 __attribute__((ext_vector_type(4)));
typedef unsigned u32x2 __attribute__((ext_vector_type(2)));
typedef __bf16 bf16x2_t __attribute__((ext_vector_type(2)));
#define DI __device__ __forceinline__

constexpr int DM = 1024, NB = 32, TL = 2048, CL = 256, TP = 2304;
constexpr int MLAT = NB * TL, MCTX = NB * CL, MTOT = MLAT + MCTX;
constexpr int FF = 2816;
constexpr int NTHREADS = 256;
#ifndef DUP_MASK
#define DUP_MASK 0
#endif
#define REPS(bit) (((DUP_MASK >> (bit)) & 1) + 1)
constexpr int SMEM_BYTES = 81408;
constexpr float LOG2E = 1.4426950408889634f;
constexpr float DN_ALPHA = 1.681792830507429f;
constexpr float LAM_INIT_B = 0.35550906759096934f;

constexpr size_t MiB = 1024ull * 1024ull;
constexpr size_t OFF_MOD = 0;
constexpr size_t OFF_ROPE = 3 * MiB + 512 * 1024;
constexpr size_t OFF_ZROW = 3 * MiB + 768 * 1024;
constexpr size_t OFF_BAR = 3 * MiB + 896 * 1024;
constexpr size_t OFF_ZB = 4 * MiB;
constexpr size_t OFF_XC = 13 * MiB;
constexpr size_t OFF_WT = 45 * MiB;
constexpr size_t OFF_H = 141 * MiB;
constexpr size_t OFF_Y = 285 * MiB;
constexpr size_t OFF_QKV = 429 * MiB;
constexpr size_t WS_NEED = 879 * MiB;

struct Params {
  const float* in[35];
  float* out;
  unsigned char* ws;
  const float* wsrc[16];
  long wdst[16];
  int wK[16], wN[16], wNpad[16], wmode[16], wtile0[17];
  int pad_;
};

enum { I_X = 0, I_C, I_CTX, I_CCTX, I_MODW, I_MODB, I_LN1G, I_LN1B, I_UPW, I_CONVW, I_CONVB, I_DOWNW, I_LN2G, I_LN2B,
       I_AQKV, I_AQN, I_AKN, I_AWO, I_BQKV, I_BLQ1, I_BLK1, I_BLQ2, I_BLK2, I_BSUB, I_BWO,
       I_CWIN, I_CGF, I_CBF, I_CGB, I_CBB, I_CNORM, I_CWO, I_DQKV, I_DRPB, I_DWO };

DI unsigned pk2(float a, float b) { f32x2 v = {a, b}; bf16x2_t r = __builtin_convertvector(v, bf16x2_t); return __builtin_bit_cast(unsigned, r); }
DI float bf2f(unsigned v) { return __uint_as_float(v << 16); }
DI float bflo(unsigned v) { return __uint_as_float(v << 16); }
DI float bfhi(unsigned v) { return __uint_as_float(v & 0xffff0000u); }
DI f32x4 mfma16(bf16x8 a, bf16x8 b, f32x4 c) { return __builtin_amdgcn_mfma_f32_16x16x32_bf16(a, b, c, 0, 0, 0); }
DI f32x16 mfma32(bf16x8 a, bf16x8 b, f32x16 c) { return __builtin_amdgcn_mfma_f32_32x32x16_bf16(a, b, c, 0, 0, 0); }
DI float fexp2(float x) { return __builtin_amdgcn_exp2f(x); }
DI float silu_f(float x) { return x * __builtin_amdgcn_rcpf(1.0f + __expf(-x)); }
DI int urow_to_p(int r) { return r < MLAT ? (r >> 11) * TP + CL + (r & 2047) : ((r - MLAT) >> 8) * TP + ((r - MLAT) & 255); }
DI int get_tid() { int t = threadIdx.x; asm volatile("" : "+v"(t)); return t; }
DI int get_bid() { int t = blockIdx.x; asm volatile("" : "+v"(t)); return __builtin_amdgcn_readfirstlane(t); }
DI int launder(int t) { asm volatile("" : "+v"(t)); return t; }
DI float shx(float v, int mask, int lane) { return __builtin_bit_cast(float, __builtin_amdgcn_ds_bpermute((lane ^ mask) << 2, __builtin_bit_cast(int, v))); }
DI int iclamp(int v, int lo, int hi) { return v < lo ? lo : (v > hi ? hi : v); }

DI void mod_item(const Params& p, int item, unsigned char* smem) {
  const int tid = get_tid(), lane = tid & 63, w = tid >> 6;
  const int li = item / 96, cg_ = item % 96;
  const int n = cg_ * 64 + lane;
  const float* W = p.in[I_MODW] + (size_t)li * DM * 6144;
  const float* c = p.in[I_C];
  const float* cc = p.in[I_CCTX];
  float* sc = (float*)smem + w * (64 * 36);
  float acc[33];
#pragma unroll
  for (int r = 0; r < 33; ++r) acc[r] = 0.f;
  for (int kc = 0; kc < 4; ++kc) {
    const int kb = w * 256 + kc * 64;
#pragma unroll
    for (int r = 0; r < 33; ++r) {
      float v = (r < 32) ? c[r * DM + kb + lane] : cc[kb + lane];
      sc[lane * 36 + r] = silu_f(v);
    }
    __builtin_amdgcn_s_waitcnt(0);
    __builtin_amdgcn_wave_barrier();
#pragma unroll 4
    for (int kk = 0; kk < 64; ++kk) {
      const float wv = __builtin_nontemporal_load(W + (size_t)(kb + kk) * 6144 + n);
      const float* s = sc + kk * 36;
#pragma unroll
      for (int r4 = 0; r4 < 8; ++r4) {
        f32x4 cv = *(const f32x4*)(s + r4 * 4);
        acc[r4 * 4 + 0] += cv[0] * wv; acc[r4 * 4 + 1] += cv[1] * wv; acc[r4 * 4 + 2] += cv[2] * wv; acc[r4 * 4 + 3] += cv[3] * wv;
      }
      acc[32] += s[32] * wv;
    }
    __builtin_amdgcn_wave_barrier();
  }
  __syncthreads();
  float* red = (float*)smem;
#pragma unroll
  for (int r = 0; r < 33; ++r) red[(w * 33 + r) * 64 + lane] = acc[r];
  __syncthreads();
  const float* bias = p.in[I_MODB] + (size_t)li * 6144;
  float* MOD = (float*)(p.ws + OFF_MOD) + (size_t)li * 33 * 6144;
  for (int e = tid; e < 33 * 64; e += NTHREADS) {
    const int r = e >> 6, l = e & 63;
    float v = red[(0 * 33 + r) * 64 + l] + red[(1 * 33 + r) * 64 + l] + red[(2 * 33 + r) * 64 + l] + red[(3 * 33 + r) * 64 + l];
    MOD[(size_t)r * 6144 + cg_ * 64 + l] = v + bias[cg_ * 64 + l];
  }
  __syncthreads();
}

DI void rope_item(const Params& p) {
  float* ROPE = (float*)(p.ws + OFF_ROPE);
  for (int e = get_tid(); e < 1024; e += NTHREADS) ((unsigned*)(p.ws + OFF_ZROW))[e] = 0u;
  const double INV[16] = {1.0, 0.5623413251903491, 0.31622776601683794, 0.1778279410038923, 0.1, 0.05623413251903491, 0.03162277660168379,
                          0.01778279410038923, 0.01, 0.005623413251903491, 0.0031622776601683794, 0.0017782794100389228, 0.001,
                          0.0005623413251903491, 0.00031622776601683794, 0.00017782794100389227};
  for (int e = get_tid(); e < 1024; e += NTHREADS) {
    const int pos = e >> 4, j = e & 15;
    double inv = 1.0;
#pragma unroll
    for (int q = 0; q < 16; ++q) inv = (j == q) ? INV[q] : inv;
    const double a = (double)pos * inv;
    const double n = __builtin_rint(a * 0.6366197723675814);
    double r = __builtin_fma(-n, 1.5707963267948966, a);
    r = __builtin_fma(-n, 6.123233995736766e-17, r);
    const double r2 = r * r;
    double sn = -1.0 / 1307674368000.0;
    sn = sn * r2 + 1.0 / 6227020800.0; sn = sn * r2 - 1.0 / 39916800.0; sn = sn * r2 + 1.0 / 362880.0; sn = sn * r2 - 1.0 / 5040.0;
    sn = sn * r2 + 1.0 / 120.0; sn = sn * r2 - 1.0 / 6.0; sn = sn * r2 + 1.0; sn = sn * r;
    double cs = 1.0 / 20922789888000.0;
    cs = cs * r2 - 1.0 / 87178291200.0; cs = cs * r2 + 1.0 / 479001600.0; cs = cs * r2 - 1.0 / 3628800.0; cs = cs * r2 + 1.0 / 40320.0;
    cs = cs * r2 - 1.0 / 720.0; cs = cs * r2 + 1.0 / 24.0; cs = cs * r2 - 0.5; cs = cs * r2 + 1.0;
    const int q4 = ((int)n) & 3;
    double so, co;
    if (q4 == 0) { so = sn; co = cs; } else if (q4 == 1) { so = cs; co = -sn; } else if (q4 == 2) { so = -sn; co = -cs; } else { so = -cs; co = sn; }
    ROPE[e * 2] = (float)co; ROPE[e * 2 + 1] = (float)so;
  }
}

DI void transpose_item(const Params& p, int t, unsigned char* smem) {
  int mi = 0;
#pragma unroll
  for (int q = 1; q < 16; ++q) mi = (t >= p.wtile0[q]) ? q : mi;
  const int lt = t - p.wtile0[mi];
  const int K = p.wK[mi], N = p.wN[mi], Npad = p.wNpad[mi], mode = p.wmode[mi];
  const int ntn = Npad >> 6;
  const int tk = lt / ntn, tn = lt % ntn;
  const float* W = p.wsrc[mi];
  bf16_t* WT = (bf16_t*)(p.ws + OFF_WT) + p.wdst[mi];
  float* tile = (float*)smem;
  const int tid = get_tid();
  {
    const int j4 = tid & 15, i4 = tid >> 4;
    const int n4 = tn * 64 + 4 * j4;
    f32x4 t4[4];
#pragma unroll
    for (int ps = 0; ps < 4; ++ps)
      t4[ps] = (n4 < N) ? __builtin_nontemporal_load((const f32x4*)(W + (size_t)(tk * 64 + ps * 16 + i4) * N + n4)) : (f32x4){0.f, 0.f, 0.f, 0.f};
#pragma unroll
    for (int ps = 0; ps < 4; ++ps) {
      float* tr = tile + (ps * 16 + i4) * 65 + 4 * j4;
      tr[0] = t4[ps][0]; tr[1] = t4[ps][1]; tr[2] = t4[ps][2]; tr[3] = t4[ps][3];
    }
  }
  __syncthreads();
  int nd0 = tn * 64;
  if (mode == 1) nd0 = (tn < 44) ? tn * 128 : (tn - 44) * 128 + 64;
  const int nl = tid >> 2, kq = tid & 3;
  unsigned w8[8];
#pragma unroll
  for (int e = 0; e < 8; ++e) {
    int k0 = kq * 16 + 2 * e, k1 = k0 + 1;
    if (mode == 2) { k0 = ((k0 >> 2) & 1) * 32 + (k0 >> 3) * 4 + (k0 & 3); k1 = ((k1 >> 2) & 1) * 32 + (k1 >> 3) * 4 + (k1 & 3); }
    w8[e] = pk2(tile[k0 * 65 + nl], tile[k1 * 65 + nl]);
  }
  u32x4* dst = (u32x4*)(WT + (size_t)(nd0 + nl) * K + tk * 64 + kq * 16);
  dst[0] = (u32x4){w8[0], w8[1], w8[2], w8[3]};
  dst[1] = (u32x4){w8[4], w8[5], w8[6], w8[7]};
  __syncthreads();
}

DI void modulate_phase(const Params& p) {
  const int tid_ = get_tid(); const int lane = tid_ & 63, wv = get_bid() * 4 + (tid_ >> 6), nw = gridDim.x * 4;
  const float* MOD = (const float*)(p.ws + OFF_MOD);
  bf16_t* H = (bf16_t*)(p.ws + OFF_H);
  auto segment = [&](int base, int count, int mrow) {
    const float* m = MOD + (size_t)mrow * 6144;
    f32x4 shr_[4], scr[4];
#pragma unroll
    for (int j = 0; j < 4; ++j) { const int c = j * 256 + lane * 4; shr_[j] = *(const f32x4*)(m + c); scr[j] = *(const f32x4*)(m + 1024 + c) + 1.0f; }
    for (int i = 0; i < count; ++i) {
      const int r = base + i;
      const float* x = r < MLAT ? p.in[I_X] + (size_t)r * DM : p.in[I_CTX] + (size_t)(r - MLAT) * DM;
#pragma unroll
      for (int j = 0; j < 4; ++j) {
        const int c = j * 256 + lane * 4;
        f32x4 xv = __builtin_nontemporal_load((const f32x4*)(x + c));
        f32x4 h = xv * scr[j] + shr_[j];
        *(u32x2*)(H + (size_t)r * DM + c) = (u32x2){pk2(h[0], h[1]), pk2(h[2], h[3])};
      }
    }
  };
  if ((nw & 31) == 0 && (2048 % (nw >> 5)) == 0) {
    const int wpb = nw >> 5, rpw = 2048 / wpb;
    const int bb_ = wv / wpb, wi = wv - bb_ * wpb;
    segment(bb_ * 2048 + wi * rpw, rpw, bb_);
  } else {
    for (int r = wv; r < MLAT; r += nw) segment(r, 1, r >> 11);
  }
  {
    const int per = (MCTX + nw - 1) / nw;
    const int c0 = wv * per;
    if (c0 < MCTX) segment(MLAT + c0, (c0 + per <= MCTX) ? per : MCTX - c0, 32);
  }
}

DI void ln_phase(const Params& p, const float* xs_lat, const float* xs_ctx, float* xd_lat, float* xd_ctx, const float* modg, int gidx,
                 const float* lg, const float* lb, const float* modh, int shidx, int scidx, int nrows, bool write_h) {
  const int tid_ = get_tid(); const int lane = tid_ & 63, wv = get_bid() * 4 + (tid_ >> 6), nw = gridDim.x * 4;
  const bf16_t* Y = (const bf16_t*)(p.ws + OFF_Y);
  bf16_t* H = (bf16_t*)(p.ws + OFF_H);
  f32x4 ggr[4], bbr[4];
#pragma unroll
  for (int j = 0; j < 4; ++j) { ggr[j] = *(const f32x4*)(lg + (j >> 1) * 512 + lane * 8 + (j & 1) * 4); bbr[j] = *(const f32x4*)(lb + (j >> 1) * 512 + lane * 8 + (j & 1) * 4); }
  auto segment = [&](int base, int count, int mrow) {
    f32x4 gvr[4], shr_[4], scr[4];
    const float* mg = modg + (size_t)mrow * 6144 + gidx * 1024;
    const float* mh = modh + (size_t)mrow * 6144;
#pragma unroll
    for (int j = 0; j < 4; ++j) {
      const int c = (j >> 1) * 512 + lane * 8 + (j & 1) * 4;
      gvr[j] = *(const f32x4*)(mg + c);
      if (write_h) { shr_[j] = *(const f32x4*)(mh + shidx * 1024 + c); scr[j] = *(const f32x4*)(mh + scidx * 1024 + c) + 1.0f; }
    }
    for (int i = 0; i < count; i += 2) {
      const float* x[2]; float* xd[2]; int rr[2]; bool ok[2];
      f32x4 v[2][4];
      float s[2];
#pragma unroll
      for (int u = 0; u < 2; ++u) {
        ok[u] = i + u < count;
        rr[u] = base + (ok[u] ? i + u : i);
        const bool lat = rr[u] < MLAT;
        x[u] = lat ? xs_lat + (size_t)rr[u] * DM : xs_ctx + (size_t)(rr[u] - MLAT) * DM;
        xd[u] = lat ? xd_lat + (size_t)rr[u] * DM : xd_ctx + (size_t)(rr[u] - MLAT) * DM;
      }
#pragma unroll
      for (int u = 0; u < 2; ++u) {
        s[u] = 0.f;
#pragma unroll
        for (int jh = 0; jh < 2; ++jh) {
          const int c = jh * 512 + lane * 8;
          f32x4 xa = __builtin_nontemporal_load((const f32x4*)(x[u] + c)), xb = __builtin_nontemporal_load((const f32x4*)(x[u] + c + 4));
          u32x4 yv = __builtin_nontemporal_load((const u32x4*)(Y + (size_t)rr[u] * DM + c));
          f32x4 ya = {bflo(yv[0]), bfhi(yv[0]), bflo(yv[1]), bfhi(yv[1])}, yb = {bflo(yv[2]), bfhi(yv[2]), bflo(yv[3]), bfhi(yv[3])};
          v[u][2 * jh] = xa * DN_ALPHA + gvr[2 * jh] * ya;
          v[u][2 * jh + 1] = xb * DN_ALPHA + gvr[2 * jh + 1] * yb;
          s[u] += ((v[u][2 * jh][0] + v[u][2 * jh][1]) + (v[u][2 * jh][2] + v[u][2 * jh][3])) + ((v[u][2 * jh + 1][0] + v[u][2 * jh + 1][1]) + (v[u][2 * jh + 1][2] + v[u][2 * jh + 1][3]));
        }
      }
#pragma unroll
      for (int o = 32; o >= 1; o >>= 1) { s[0] += shx(s[0], o, lane); s[1] += shx(s[1], o, lane); }
      float mu[2], q[2];
#pragma unroll
      for (int u = 0; u < 2; ++u) {
        mu[u] = s[u] * (1.0f / 1024.0f); q[u] = 0.f;
#pragma unroll
        for (int j = 0; j < 4; ++j) { f32x4 d = v[u][j] - mu[u]; q[u] += (d[0] * d[0] + d[1] * d[1]) + (d[2] * d[2] + d[3] * d[3]); }
      }
#pragma unroll
      for (int o = 32; o >= 1; o >>= 1) { q[0] += shx(q[0], o, lane); q[1] += shx(q[1], o, lane); }
#pragma unroll
      for (int u = 0; u < 2; ++u) {
        if (!ok[u]) continue;
        const float rstd = rsqrtf(q[u] * (1.0f / 1024.0f) + 1e-5f);
#pragma unroll
        for (int jh = 0; jh < 2; ++jh) {
          const int c = jh * 512 + lane * 8;
          f32x4 oa = (v[u][2 * jh] - mu[u]) * rstd * ggr[2 * jh] + bbr[2 * jh];
          f32x4 ob = (v[u][2 * jh + 1] - mu[u]) * rstd * ggr[2 * jh + 1] + bbr[2 * jh + 1];
          __builtin_nontemporal_store(oa, (f32x4*)(xd[u] + c));
          __builtin_nontemporal_store(ob, (f32x4*)(xd[u] + c + 4));
          if (write_h) {
            f32x4 ha = oa * scr[2 * jh] + shr_[2 * jh], hb = ob * scr[2 * jh + 1] + shr_[2 * jh + 1];
            *(u32x4*)(H + (size_t)rr[u] * DM + c) = (u32x4){pk2(ha[0], ha[1]), pk2(ha[2], ha[3]), pk2(hb[0], hb[1]), pk2(hb[2], hb[3])};
          }
        }
      }
    }
  };
  if ((nw & 31) == 0 && (2048 % (nw >> 5)) == 0) {
    const int wpb = nw >> 5, rpw = 2048 / wpb;
    const int bb_ = wv / wpb, wi = wv - bb_ * wpb;
    segment(bb_ * 2048 + wi * rpw, rpw, bb_);
  } else {
    for (int r = wv; r < MLAT; r += nw) segment(r, 1, r >> 11);
  }
  if (nrows > MLAT) {
    const int nctx = nrows - MLAT;
    const int per = (nctx + nw - 1) / nw;
    const int c0 = wv * per;
    if (c0 < nctx) segment(MLAT + c0, (c0 + per <= nctx) ? per : nctx - c0, 32);
  }
}

DI void gla_finish_phase(const Params& p) {
  const int tid_ = get_tid(); const int lane = tid_ & 63, wv = get_bid() * 4 + (tid_ >> 6), nw = gridDim.x * 4;
  bf16_t* OF = (bf16_t*)(p.ws + OFF_H);
  const bf16_t* OB = (const bf16_t*)(p.ws + OFF_Y);
  const bf16_t* OG = (const bf16_t*)(p.ws + OFF_QKV) + (size_t)MTOT * 512 * 2 + (size_t)NB * 1024 * TP;
  const float* ng = p.in[I_CNORM];
  float gpr[16];
#pragma unroll
  for (int e4 = 0; e4 < 4; ++e4) { f32x4 t = *(const f32x4*)(ng + (lane & 15) * 16 + e4 * 4); gpr[e4 * 4] = t[0]; gpr[e4 * 4 + 1] = t[1]; gpr[e4 * 4 + 2] = t[2]; gpr[e4 * 4 + 3] = t[3]; }
  for (int r = wv; r < MTOT; r += nw) {
    const size_t off = (size_t)r * DM + lane * 16;
    float o[16], g[16];
#pragma unroll
    for (int h2 = 0; h2 < 2; ++h2) {
      u32x4 a = __builtin_nontemporal_load((const u32x4*)(OF + off + h2 * 8)), b = __builtin_nontemporal_load((const u32x4*)(OB + off + h2 * 8)), c = __builtin_nontemporal_load((const u32x4*)(OG + off + h2 * 8));
#pragma unroll
      for (int e = 0; e < 4; ++e) {
        o[h2 * 8 + 2 * e] = bflo(a[e]) + bflo(b[e]); o[h2 * 8 + 2 * e + 1] = bfhi(a[e]) + bfhi(b[e]);
        g[h2 * 8 + 2 * e] = bflo(c[e]); g[h2 * 8 + 2 * e + 1] = bfhi(c[e]);
      }
    }
    float ss = 0.f;
#pragma unroll
    for (int e = 0; e < 16; ++e) ss += o[e] * o[e];
    ss += shx(ss, 1, lane); ss += shx(ss, 2, lane); ss += shx(ss, 4, lane); ss += shx(ss, 8, lane);
    const float rinv = rsqrtf(ss * (1.0f / 256.0f) + 1e-6f);
    unsigned w[8];
#pragma unroll
    for (int e = 0; e < 8; ++e) {
      float v0 = o[2 * e] * rinv * gpr[2 * e] * silu_f(g[2 * e]);
      float v1 = o[2 * e + 1] * rinv * gpr[2 * e + 1] * silu_f(g[2 * e + 1]);
      w[e] = pk2(v0, v1);
    }
    *(u32x4*)(OF + off) = (u32x4){w[0], w[1], w[2], w[3]};
    *(u32x4*)(OF + off + 8) = (u32x4){w[4], w[5], w[6], w[7]};
  }
}

constexpr int GB_BUF = 128 * 80;
template <bool SW>
DI void gemm_kloop(f32x4 (&acc)[4][8], const bf16_t* Abase, const unsigned (&aoff)[4], const bf16_t* Bg, int K, unsigned char* smem) {
  const int tid = get_tid(), lane = tid & 63, fr = lane & 15, fq = lane >> 4;
  const int brow = tid >> 2, bch = tid & 3;
  const int nk = K >> 5;
  const unsigned boff0 = (unsigned)((brow * K + bch * 8) * 2), boff1 = boff0 + (unsigned)(64 * K * 2);
  const unsigned char* Ab = (const unsigned char*)Abase;
  const unsigned char* Bb = (const unsigned char*)Bg;
  unsigned char* bdst = smem + brow * 80 + bch * 16;
  const unsigned char* bs = smem + fr * 80 + fq * 16;
  bf16x8 a0[4], a1[4];
  u32x4 rb[2];
#define G_LOADA(dst, kt) _Pragma("unroll") for (int m = 0; m < 4; ++m) { dst[m] = *(const bf16x8*)(Ab + (aoff[m] + (unsigned)(kt) * 64u)); }
#define G_LOADB(kt) { rb[0] = *(const u32x4*)(Bb + (boff0 + (unsigned)(kt) * 64u)); rb[1] = *(const u32x4*)(Bb + (boff1 + (unsigned)(kt) * 64u)); }
#define G_STOREB(buf) { *(u32x4*)(bdst + (buf) * GB_BUF) = rb[0]; *(u32x4*)(bdst + (buf) * GB_BUF + 64 * 80) = rb[1]; }
#define G_COMPUTE(af, buf) _Pragma("unroll") for (int nh = 0; nh < 2; ++nh) { \
    bf16x8 bfr[4]; \
    _Pragma("unroll") for (int n = 0; n < 4; ++n) bfr[n] = *(const bf16x8*)(bs + (buf) * GB_BUF + (nh * 4 + n) * 16 * 80); \
    __builtin_amdgcn_s_setprio(1); \
    _Pragma("unroll") for (int m = 0; m < 4; ++m) \
    _Pragma("unroll") for (int n = 0; n < 4; ++n) acc[m][nh * 4 + n] = SW ? mfma16(bfr[n], af[m], acc[m][nh * 4 + n]) : mfma16(af[m], bfr[n], acc[m][nh * 4 + n]); \
    __builtin_amdgcn_s_setprio(0); }
  G_LOADA(a0, 0); G_LOADB(0); G_STOREB(0); __syncthreads();
  for (int kt = 0; kt < nk; kt += 2) {
    G_LOADA(a1, kt + 1); G_LOADB(kt + 1);
    G_COMPUTE(a0, 0);
    G_STOREB(1);
    __syncthreads();
    if (kt + 2 < nk) { G_LOADA(a0, kt + 2); G_LOADB(kt + 2); }
    G_COMPUTE(a1, 1);
    if (kt + 2 < nk) G_STOREB(0);
    __syncthreads();
  }
#undef G_LOADA
#undef G_LOADB
#undef G_STOREB
#undef G_COMPUTE
}

constexpr int GBF_BUF = 128 * 144;
template <bool SW, bool DB = false>
DI void gemm_kloopF(f32x4 (&acc)[4][8], const bf16_t* Abase, const unsigned (&aoff)[4], const bf16_t* Bg, int K, unsigned char* smem) {
  const int tid = get_tid(), lane = tid & 63, fr = lane & 15, fq = lane >> 4;
  const int brow = tid >> 3, bch = tid & 7;
  const int nk = K >> 6;
  const unsigned boff = (unsigned)((brow * K + bch * 8) * 2), bstep = (unsigned)(32 * K * 2);
  const unsigned char* Ab = (const unsigned char*)Abase;
  const unsigned char* Bb = (const unsigned char*)Bg;
  unsigned char* bdst = smem + brow * 144 + bch * 16;
  const unsigned char* bs = smem + fr * 144 + fq * 16;
  bf16x8 X[4], Y[4], Z[4];
  u32x4 rb[2];
#define G_LOADG(D, g, ks) { \
    D[0] = *(const bf16x8*)(Ab + (aoff[2 * (g)] + (unsigned)(ks) * 128u)); D[1] = *(const bf16x8*)(Ab + (aoff[2 * (g)] + (unsigned)(ks) * 128u + 64u)); \
    D[2] = *(const bf16x8*)(Ab + (aoff[2 * (g) + 1] + (unsigned)(ks) * 128u)); D[3] = *(const bf16x8*)(Ab + (aoff[2 * (g) + 1] + (unsigned)(ks) * 128u + 64u)); }
#define G_LOADB(ks, h) _Pragma("unroll") for (int j = 0; j < 2; ++j) rb[j] = *(const u32x4*)(Bb + (boff + (unsigned)(2 * (h) + j) * bstep + (unsigned)(ks) * 128u));
#define G_STOREB(buf, h) _Pragma("unroll") for (int j = 0; j < 2; ++j) *(u32x4*)(bdst + (buf) * GBF_BUF + (2 * (h) + j) * 32 * 144) = rb[j];
#define G_BLD(dst, buf, q) _Pragma("unroll") for (int n = 0; n < 4; ++n) dst[n] = *(const bf16x8*)(bs + (buf) * GBF_BUF + ((((q) & 1) * 4 + n) * 16 * 144) + ((q) >> 1) * 64);
#define G_MM(D, g, bfr, q) _Pragma("unroll") for (int mm = 0; mm < 2; ++mm) \
    _Pragma("unroll") for (int n = 0; n < 4; ++n) acc[2 * (g) + mm][((q) & 1) * 4 + n] = SW ? mfma16(bfr[n], D[2 * mm + ((q) >> 1)], acc[2 * (g) + mm][((q) & 1) * 4 + n]) : mfma16(D[2 * mm + ((q) >> 1)], bfr[n], acc[2 * (g) + mm][((q) & 1) * 4 + n]);
#define G_COMPG(D, g, buf) { if (!DB) { _Pragma("unroll") for (int q = 0; q < 4; ++q) { \
      __builtin_amdgcn_sched_barrier(0); \
      bf16x8 bfr[4]; G_BLD(bfr, buf, q); G_MM(D, g, bfr, q); } \
    } else { \
      bf16x8 b0[4], b1[4]; \
      __builtin_amdgcn_sched_barrier(0); G_BLD(b0, buf, 0); \
      __builtin_amdgcn_sched_barrier(0); G_BLD(b1, buf, 1); G_MM(D, g, b0, 0); \
      __builtin_amdgcn_sched_barrier(0); G_BLD(b0, buf, 2); G_MM(D, g, b1, 1); \
      __builtin_amdgcn_sched_barrier(0); G_BLD(b1, buf, 3); G_MM(D, g, b0, 2); \
      __builtin_amdgcn_sched_barrier(0); G_MM(D, g, b1, 3); } }
#define G_STEP(C0, C1, SP, ks) { \
    const bool more_ = (ks) + 1 < nk; \
    if (more_) { G_LOADB((ks) + 1, 0); G_LOADG(SP, 0, (ks) + 1); } \
    G_COMPG(C0, 0, (ks) & 1); \
    if (more_) { G_STOREB(((ks) + 1) & 1, 0); G_LOADB((ks) + 1, 1); G_LOADG(C0, 1, (ks) + 1); } \
    G_COMPG(C1, 1, (ks) & 1); \
    if (more_) { G_STOREB(((ks) + 1) & 1, 1); } \
    __syncthreads(); }
  G_LOADG(X, 0, 0); G_LOADG(Y, 1, 0); G_LOADB(0, 0); G_STOREB(0, 0); G_LOADB(0, 1); G_STOREB(0, 1); __syncthreads();
  for (int ks = 0; ks < nk; ks += 3) {
    G_STEP(X, Y, Z, ks);
    if (ks + 1 < nk) G_STEP(Z, X, Y, ks + 1);
    if (ks + 2 < nk) G_STEP(Y, Z, X, ks + 2);
  }
#undef G_STEP
#undef G_COMPG
#undef G_MM
#undef G_BLD
#undef G_STOREB
#undef G_LOADB
#undef G_LOADG
}

DI void tile_remap(int L, int nM, int nN, int& pm, int& pn) {
  const int nwg = nM * nN;
  int wgid = L;
  { const int q = nwg / 8, r = nwg % 8, xcd = wgid % 8, off = wgid / 8; wgid = (xcd < r ? xcd * (q + 1) : r * (q + 1) + (xcd - r) * q) + off; }
  const int nig = 8 * nN, gid = wgid / nig, fm = gid * 8, gsz = (nM - fm) < 8 ? (nM - fm) : 8;
  pm = fm + ((wgid % nig) % gsz); pn = (wgid % nig) / gsz;
}

#define ACC_ZERO(acc) _Pragma("unroll") for (int m = 0; m < 4; ++m) _Pragma("unroll") for (int n = 0; n < 8; ++n) acc[m][n] = (f32x4){0.f, 0.f, 0.f, 0.f};

DI void gemm_plain_phase(const Params& p, const bf16_t* A, int K, const bf16_t* Bt, bf16_t* C, int nM, unsigned char* smem) {
  const int tid = get_tid(), lane = tid & 63, wid = tid >> 6, fr = lane & 15, fq = lane >> 4;
  const int nN = 8, nwg = nM * nN;
  for (int L = get_bid(); L < nwg; L += gridDim.x) {
    int pm, pn; tile_remap(L, nM, nN, pm, pn);
    const int rowbase = pm * 256 + wid * 64;
    unsigned aoff[4];
#pragma unroll
    for (int m = 0; m < 4; ++m) aoff[m] = (unsigned)(((rowbase + m * 16 + fr) * K + fq * 8)) * 2u;
    f32x4 acc[4][8];
    ACC_ZERO(acc);
    gemm_kloopF<true, true>(acc, A, aoff, Bt + (size_t)pn * 128 * K, K, smem);
    unsigned char* Tw = smem + wid * 17408;
#pragma unroll
    for (int m = 0; m < 4; ++m)
#pragma unroll
      for (int n = 0; n < 8; ++n)
        *(u32x2*)(Tw + (m * 16 + fr) * 272 + (n * 16 + 4 * fq) * 2) = (u32x2){pk2(acc[m][n][0], acc[m][n][1]), pk2(acc[m][n][2], acc[m][n][3])};
    __builtin_amdgcn_sched_barrier(0);
#pragma unroll 2
    for (int it = 0; it < 16; ++it) {
      const int row = it * 4 + (lane >> 4), ch = lane & 15;
      *(u32x4*)(C + (size_t)(rowbase + row) * 1024 + pn * 128 + ch * 8) = *(const u32x4*)(Tw + row * 272 + ch * 16);
    }
    __syncthreads();
  }
}

struct QkvCfg { int kind, nq, nk, nv, ntiles; float qscale; };
DI void gemm_qkv_phase(const Params& p, const QkvCfg cfg, const bf16_t* Bt, const float* qn, const float* kn, unsigned char* smem) {
  const int tid = get_tid(), lane = tid & 63, wid = tid >> 6, fr = lane & 15, fq = lane >> 4;
  const bf16_t* A = (const bf16_t*)(p.ws + OFF_H);
  bf16_t* Qb = (bf16_t*)(p.ws + OFF_QKV);
  bf16_t* Kb = Qb + (size_t)MTOT * cfg.nq;
  bf16_t* VTb = Kb + (size_t)MTOT * cfg.nk;
  bf16_t* OGb = VTb + (size_t)NB * cfg.nv * TP;
  float* ZB = (float*)(p.ws + OFF_ZB);
  const float* ROPE = (const float*)(p.ws + OFF_ROPE);
  const int nM = MTOT / 256, nN = cfg.ntiles, nwg = nM * nN;
  const int K = 1024;
  const int v0c = cfg.nq + cfg.nk, v1c = v0c + cfg.nv;
  for (int L = get_bid(); L < nwg; L += gridDim.x) {
    int pm, pn; tile_remap(L, nM, nN, pm, pn);
    const int rowbase = pm * 256 + wid * 64;
    unsigned aoff[4];
#pragma unroll
    for (int m = 0; m < 4; ++m) aoff[m] = (unsigned)(((rowbase + m * 16 + fr) * K + fq * 8)) * 2u;
    f32x4 acc[4][8];
    ACC_ZERO(acc);
    const int col0 = pn * 128;
    if (cfg.kind == 3 && pm * 256 >= MLAT && col0 < cfg.nq) continue;
    const bool vtile = (col0 >= v0c) && (col0 < v1c);
    if (vtile) {
      gemm_kloopF<false, false>(acc, A, aoff, Bt + (size_t)pn * 128 * K, K, smem);
      unsigned char* Tv = smem + wid * 18432;
#pragma unroll
      for (int m = 0; m < 4; ++m)
#pragma unroll
        for (int n = 0; n < 8; ++n)
          *(u32x2*)(Tv + (n * 16 + fr) * 144 + (m * 16 + 4 * fq) * 2) = (u32x2){pk2(acc[m][n][0], acc[m][n][1]), pk2(acc[m][n][2], acc[m][n][3])};
      __builtin_amdgcn_sched_barrier(0);
      {
        const int P0 = urow_to_p(rowbase);
        const int b = P0 / TP, kidx0 = P0 - b * TP;
        bf16_t* dst0 = VTb + ((size_t)(b * cfg.nv + (col0 - v0c))) * TP + kidx0;
#pragma unroll 2
        for (int it = 0; it < 16; ++it) {
          const int vc = it * 8 + (lane >> 3), ch = lane & 7;
          __builtin_nontemporal_store(*(const u32x4*)(Tv + vc * 144 + ch * 16), (u32x4*)(dst0 + (size_t)vc * TP + ch * 8));
        }
      }
    } else {
      gemm_kloop<true>(acc, A, aoff, Bt + (size_t)pn * 128 * K, K, smem);
      const bool isq = col0 < cfg.nq, isk = (!isq) && col0 < v0c;
      const bool isz = (!isq) && (!isk) && !(col0 < v1c + 1024);
      unsigned char* Tw = smem + wid * 17408;
      const bool lat = pm * 256 < MLAT;
      const bool do_rms = (cfg.kind == 0) && (isq || isk);
      const bool do_rope = (cfg.kind <= 1) && (isq || isk) && lat;
      const float scl = isq ? cfg.qscale : 1.0f;
      const float* nw = isq ? qn : kn;
#pragma unroll
      for (int hd = 0; hd < 2; ++hd) {
        const int cw = col0 + hd * 64;
#pragma unroll
        for (int m = 0; m < 4; ++m) {
          __builtin_amdgcn_sched_barrier(0);
          const int ur = rowbase + m * 16 + fr;
          const int P = urow_to_p(ur);
          float v[4][4];
#pragma unroll
          for (int n = 0; n < 4; ++n)
#pragma unroll
            for (int r = 0; r < 4; ++r) v[n][r] = acc[m][hd * 4 + n][r];
          if (do_rms) {
            float ss = 0.f;
#pragma unroll
            for (int n = 0; n < 4; ++n)
#pragma unroll
              for (int r = 0; r < 4; ++r) ss += v[n][r] * v[n][r];
            ss += shx(ss, 16, lane); ss += shx(ss, 32, lane);
            const float rinv = rsqrtf(ss * (1.0f / 64.0f) + 1e-6f);
#pragma unroll
            for (int n = 0; n < 4; ++n) {
              f32x4 g = *(const f32x4*)(nw + n * 16 + 4 * fq);
#pragma unroll
              for (int r = 0; r < 4; ++r) v[n][r] = v[n][r] * rinv * g[r];
            }
          }
          if (do_rope) {
            const int t = ur & 2047;
            const int prow = t >> 6, pcol = t & 63;
#pragma unroll
            for (int n = 0; n < 2; ++n) {
              const int pos = n == 0 ? prow : pcol;
              const float* rp = ROPE + (pos * 16 + 4 * fq) * 2;
              f32x4 c0 = *(const f32x4*)(rp), c1 = *(const f32x4*)(rp + 4);
              const float cs[4] = {c0[0], c0[2], c1[0], c1[2]}, sn[4] = {c0[1], c0[3], c1[1], c1[3]};
#pragma unroll
              for (int r = 0; r < 4; ++r) {
                const float x1 = v[n][r], x2 = v[n + 2][r];
                v[n][r] = x1 * cs[r] - x2 * sn[r];
                v[n + 2][r] = x1 * sn[r] + x2 * cs[r];
              }
            }
          }
          if (!isz) {
#pragma unroll
            for (int n = 0; n < 4; ++n)
              *(u32x2*)(Tw + (m * 16 + fr) * 272 + (hd * 64 + n * 16 + 4 * fq) * 2) = (u32x2){pk2(v[n][0] * scl, v[n][1] * scl), pk2(v[n][2] * scl, v[n][3] * scl)};
          } else {
            if (hd == 0) {
#pragma unroll
              for (int n = 0; n < 2; ++n) *(f32x4*)(ZB + (size_t)P * 32 + n * 16 + 4 * fq) = (f32x4){v[n][0], v[n][1], v[n][2], v[n][3]};
            }
          }
        }
      }
      __builtin_amdgcn_sched_barrier(0);
      if (!isz) {
        bf16_t* dst0;
        int ld;
        if (isq) { dst0 = Qb + (size_t)urow_to_p(rowbase) * cfg.nq + col0; ld = cfg.nq; }
        else if (isk) { dst0 = Kb + (size_t)urow_to_p(rowbase) * cfg.nk + (col0 - cfg.nq); ld = cfg.nk; }
        else { dst0 = OGb + (size_t)rowbase * 1024 + (col0 - v1c); ld = 1024; }
#pragma unroll 2
        for (int it = 0; it < 16; ++it) {
          const int row = it * 4 + (lane >> 4), ch = lane & 15;
          __builtin_nontemporal_store(*(const u32x4*)(Tw + row * 272 + ch * 16), (u32x4*)(dst0 + (size_t)row * ld + ch * 8));
        }
      }
    }
    __syncthreads();
  }
}

DI float dpp_prev(float v) { float o; asm volatile("v_mov_b32_dpp %0, %1 row_ror:1 row_mask:0xf bank_mask:0xf" : "=v"(o) : "v"(v)); return o; }
DI float dpp_next(float v) { float o; asm volatile("v_mov_b32_dpp %0, %1 row_ror:15 row_mask:0xf bank_mask:0xf" : "=v"(o) : "v"(v)); return o; }
DI void gemm_ffn_up_phase(const Params& p, int layer, const bf16_t* Bt, bool with_ctx, unsigned char* smem) {
  const int tid = get_tid(), lane = tid & 63, wid = tid >> 6, fr = lane & 15, fq = lane >> 4;
  bf16_t* U = (bf16_t*)(p.ws + OFF_QKV);
  const bf16_t* ZROW = (const bf16_t*)(p.ws + OFF_ZROW);
  const float* cw = p.in[I_CONVW] + (size_t)layer * 3 * 5632;
  const float* cb = p.in[I_CONVB] + (size_t)layer * 5632;
  const int nM = with_ctx ? 292 : 259, nN = 44, nwg = nM * nN;
  const int K = 1024;
  for (int L = get_bid(); L < nwg; L += gridDim.x) {
    int pm, pn; tile_remap(L, nM, nN, pm, pn);
    int sbase, slen, sqm, kk;
    if (pm < 259) { kk = pm; sbase = 0; slen = MLAT; sqm = 2047; } else { kk = pm - 259; sbase = MLAT; slen = MCTX; sqm = 255; }
    const int t0 = 254 * kk - 1;
    unsigned aoff[4];
#pragma unroll
    for (int m = 0; m < 4; ++m) {
      const int t = t0 + wid * 64 + m * 16 + fr;
      const bool ok = (t >= 0) && (t < slen);
      aoff[m] = ok ? (unsigned)(OFF_H - OFF_ZROW) + (unsigned)(((sbase + t) * K + fq * 8)) * 2u : (unsigned)(fq * 16);
    }
    f32x4 acc[4][8];
    ACC_ZERO(acc);
    gemm_kloopF<true, true>(acc, ZROW, aoff, Bt + (size_t)pn * 128 * K, K, smem);
    {
      float* Tall = (float*)smem;
      float* Tw = Tall + wid * (64 * 68);
      const int c4 = (lane & 7) * 4, i0 = (lane >> 3) * 8;
#pragma unroll
      for (int hf = 0; hf < 2; ++hf) {
        __builtin_amdgcn_sched_barrier(0);
#pragma unroll
        for (int m = 0; m < 4; ++m)
#pragma unroll
          for (int j = 0; j < 2; ++j) {
            *(f32x4*)(Tw + (m * 16 + fr) * 68 + j * 16 + 4 * fq) = acc[m][2 * hf + j];
            *(f32x4*)(Tw + (m * 16 + fr) * 68 + 32 + j * 16 + 4 * fq) = acc[m][4 + 2 * hf + j];
          }
        __syncthreads();
        const int cgi = pn * 64 + hf * 32 + c4, cvi = FF + cgi;
        const f32x4 g0 = *(const f32x4*)(cw + cgi), g1 = *(const f32x4*)(cw + 5632 + cgi), g2 = *(const f32x4*)(cw + 2 * 5632 + cgi), gb = *(const f32x4*)(cb + cgi);
        const f32x4 v0 = *(const f32x4*)(cw + cvi), v1 = *(const f32x4*)(cw + 5632 + cvi), v2 = *(const f32x4*)(cw + 2 * 5632 + cvi), vb = *(const f32x4*)(cb + cvi);
        const int I0 = wid * 64 + i0;
        const int Ip = I0 > 0 ? I0 - 1 : 0;
        f32x4 pg = *(const f32x4*)(Tall + Ip * 68 + c4), pv = *(const f32x4*)(Tall + Ip * 68 + 32 + c4);
        f32x4 cg2 = *(const f32x4*)(Tall + I0 * 68 + c4), cv2 = *(const f32x4*)(Tall + I0 * 68 + 32 + c4);
#pragma unroll
        for (int ii = 0; ii < 8; ++ii) {
          const int I = I0 + ii;
          const int In = I < 255 ? I + 1 : 255;
          const f32x4 ng_ = *(const f32x4*)(Tall + In * 68 + c4), nv_ = *(const f32x4*)(Tall + In * 68 + 32 + c4);
          const int t = t0 + I;
          const int pos = t & sqm;
          const float mp = (pos == 0) ? 0.f : 1.f, mn = (pos == sqm) ? 0.f : 1.f;
          const f32x4 G = gb + g0 * (pg * mp) + g1 * cg2 + g2 * (ng_ * mn);
          const f32x4 V = vb + v0 * (pv * mp) + v1 * cv2 + v2 * (nv_ * mn);
          const unsigned w0 = pk2(silu_f(G[0]) * V[0], silu_f(G[1]) * V[1]), w1 = pk2(silu_f(G[2]) * V[2], silu_f(G[3]) * V[3]);
          if (I >= 1 && I <= 254 && t < slen)
            __builtin_nontemporal_store((u32x2){w0, w1}, (u32x2*)(U + (size_t)(sbase + t) * FF + cgi));
          pg = cg2; pv = cv2; cg2 = ng_; cv2 = nv_;
        }
        __syncthreads();
      }
    }
  }
}

template <int DV, bool NBM>
DI void flash_core(f32x16 (&oacc)[DV / 32], float& l_out, const bf16_t* qptr, const bf16_t* kbase, int ldk, const bf16_t* vtbase, int ldv,
                   int s0, int n0, int s1, int n1, unsigned char* smem,
                   int rq, int r0q, int r0a, const float* rpbL, int cq) {
  constexpr int NDB = DV / 32;
  constexpr int BUFB = 9216 + DV * 144;
  const int tid = get_tid(), lane = tid & 63, l31 = lane & 31, half = lane >> 5;
  const int lrow = tid >> 3, lch = tid & 7;
  bf16x8 qf[4];
#pragma unroll
  for (int ks = 0; ks < 4; ++ks) qf[ks] = *(const bf16x8*)(qptr + ks * 16 + half * 8);
  float m_run = 0.f, l_run = 0.f;
  f32x16 negm;
#pragma unroll
  for (int r = 0; r < 16; ++r) negm[r] = 0.f;
#pragma unroll
  for (int db = 0; db < NDB; ++db)
#pragma unroll
    for (int r = 0; r < 16; ++r) oacc[db][r] = 0.f;
  u32x4 rkA[2], rvA[NDB], rkB[2], rvB[NDB];
  const int ntl = n0 + n1;
  auto gload = [&](int it, u32x4 (&rk)[2], u32x4 (&rv)[NDB]) {
    const int key0 = it < n0 ? s0 + it * 64 : s1 + (it - n0) * 64;
#pragma unroll
    for (int j = 0; j < 2; ++j) rk[j] = *(const u32x4*)(kbase + (long)(key0 + lrow + 32 * j) * ldk + lch * 8);
#pragma unroll
    for (int j = 0; j < NDB; ++j) rv[j] = *(const u32x4*)(vtbase + (long)(lrow + 32 * j) * ldv + key0 + lch * 8);
  };
  auto sstore = [&](int buf, const u32x4 (&rk)[2], const u32x4 (&rv)[NDB]) {
    unsigned char* ks_ = smem + buf * BUFB;
#pragma unroll
    for (int j = 0; j < 2; ++j) *(u32x4*)(ks_ + (lrow + 32 * j) * 144 + lch * 16) = rk[j];
#pragma unroll
    for (int j = 0; j < NDB; ++j) *(u32x4*)(ks_ + 9216 + (lrow + 32 * j) * 144 + ((lch ^ ((lrow >> 3) & 3)) * 16)) = rv[j];
  };
  const int c0 = iclamp(cq - 8, 0, 48);
  const int x16 = ((l31 >> 3) & 3) << 4;
  auto compute = [&](int it) {
    bool active = true;
    int dr = 0;
    if (NBM && it >= n0) { const int rr = r0a + (it - n0); active = (rr >= r0q) && (rr < r0q + 8); dr = rr - rq + 7; }
    if (active) {
      const unsigned char* ks_ = smem + (it & 1) * BUFB;
      const unsigned char* vs_ = ks_ + 9216;
      f32x16 s[2];
#pragma unroll
      for (int kb = 0; kb < 2; ++kb) {
#pragma unroll
        for (int ks = 0; ks < 4; ++ks) {
          bf16x8 a = *(const bf16x8*)(ks_ + (kb * 32 + l31) * 144 + (ks * 16 + half * 8) * 2);
          __builtin_amdgcn_s_setprio(1);
          s[kb] = mfma32(a, qf[ks], ks == 0 ? negm : s[kb]);
          __builtin_amdgcn_s_setprio(0);
        }
      }
      if (NBM && it >= n0) {
#pragma unroll
        for (int kb = 0; kb < 2; ++kb)
#pragma unroll
          for (int r = 0; r < 16; ++r) {
            const int ck = kb * 32 + 8 * (r >> 2) + 4 * half + (r & 3);
            const bool inw = (ck >= c0) && (ck < c0 + 16);
            const int dc = iclamp(ck - cq, -15, 15) + 15;
            const float bias = rpbL[dr * 31 + dc];
            s[kb][r] = inw ? s[kb][r] + bias : -1e30f;
          }
      }
      float mx = s[0][0];
#pragma unroll
      for (int kb = 0; kb < 2; ++kb)
#pragma unroll
        for (int r = 0; r < 16; ++r) mx = fmaxf(mx, s[kb][r]);
      const bool first = (it == 0);
      if (first || __any(mx > 8.0f)) {
        mx = fmaxf(mx, shx(mx, 32, lane));
        const float delta = first ? mx : fmaxf(mx, 0.f);
        const float alpha = first ? 0.f : fexp2(-delta);
        m_run += delta;
#pragma unroll
        for (int kb = 0; kb < 2; ++kb)
#pragma unroll
          for (int r = 0; r < 16; ++r) s[kb][r] -= delta;
        l_run *= alpha;
#pragma unroll
        for (int db = 0; db < NDB; ++db)
#pragma unroll
          for (int r = 0; r < 16; ++r) oacc[db][r] *= alpha;
#pragma unroll
        for (int r = 0; r < 16; ++r) negm[r] = -m_run;
      }
      float ps = 0.f;
#pragma unroll
      for (int kb = 0; kb < 2; ++kb)
#pragma unroll
        for (int r = 0; r < 16; ++r) { const float pe = fexp2(s[kb][r]); s[kb][r] = pe; ps += pe; }
      l_run += ps;
#pragma unroll
      for (int kb = 0; kb < 2; ++kb)
#pragma unroll
        for (int j = 0; j < 2; ++j) {
          __builtin_amdgcn_sched_barrier(0);
          u32x4 pw = {pk2(s[kb][8 * j + 0], s[kb][8 * j + 1]), pk2(s[kb][8 * j + 2], s[kb][8 * j + 3]),
                      pk2(s[kb][8 * j + 4], s[kb][8 * j + 5]), pk2(s[kb][8 * j + 6], s[kb][8 * j + 7])};
          const bf16x8 pb = __builtin_bit_cast(bf16x8, pw);
#pragma unroll
          for (int db = 0; db < NDB; ++db) {
            const unsigned char* va = vs_ + (db * 32 + l31) * 144 + half * 8;
            u32x2 v0 = *(const u32x2*)(va + (((kb * 4 + j * 2) << 4) ^ x16)), v1 = *(const u32x2*)(va + (((kb * 4 + j * 2 + 1) << 4) ^ x16));
            u32x4 vw = {v0[0], v0[1], v1[0], v1[1]};
            __builtin_amdgcn_s_setprio(1);
            oacc[db] = mfma32(__builtin_bit_cast(bf16x8, vw), pb, oacc[db]);
            __builtin_amdgcn_s_setprio(0);
          }
        }
    }
  };
  gload(0, rkA, rvA); sstore(0, rkA, rvA); __syncthreads();
  if (ntl > 1) gload(1, rkA, rvA);
  for (int it = 0; it < ntl; it += 2) {
    if (it + 2 < ntl) gload(it + 2, rkB, rvB);
    compute(it);
    if (it + 1 < ntl) sstore((it + 1) & 1, rkA, rvA);
    __syncthreads();
    if (it + 1 < ntl) {
      if (it + 3 < ntl) gload(it + 3, rkA, rvA);
      compute(it + 1);
      if (it + 2 < ntl) sstore((it + 2) & 1, rkB, rvB);
      __syncthreads();
    }
  }
  l_out = l_run + shx(l_run, 32, lane);
}


DI void flash_core_q64(f32x16 (&oacc)[2][2], float (&l_out)[2], const bf16_t* qptr0, const bf16_t* qptr1, const bf16_t* kbase, int ldk,
                       const bf16_t* vtbase, int ldv, int ntl, unsigned char* smem) {
  constexpr int BUFB = 9216 + 64 * 144;
  const int tid = get_tid(), lane = tid & 63, l31 = lane & 31, half = lane >> 5;
  const int lrow = tid >> 3, lch = tid & 7;
  bf16x8 qf[2][4];
#pragma unroll
  for (int ks = 0; ks < 4; ++ks) { qf[0][ks] = *(const bf16x8*)(qptr0 + ks * 16 + half * 8); qf[1][ks] = *(const bf16x8*)(qptr1 + ks * 16 + half * 8); }
  float m_run[2] = {0.f, 0.f}, l_run[2] = {0.f, 0.f};
#pragma unroll
  for (int qb = 0; qb < 2; ++qb)
#pragma unroll
    for (int db = 0; db < 2; ++db)
#pragma unroll
      for (int r = 0; r < 16; ++r) oacc[qb][db][r] = 0.f;
  u32x4 rk[2], rv[2];
  auto gload = [&](int it) {
    const int key0 = it * 64;
#pragma unroll
    for (int j = 0; j < 2; ++j) rk[j] = *(const u32x4*)(kbase + (long)(key0 + lrow + 32 * j) * ldk + lch * 8);
#pragma unroll
    for (int j = 0; j < 2; ++j) rv[j] = *(const u32x4*)(vtbase + (long)(lrow + 32 * j) * ldv + key0 + lch * 8);
  };
  auto sstore = [&](int buf) {
    unsigned char* ks_ = smem + buf * BUFB;
#pragma unroll
    for (int j = 0; j < 2; ++j) *(u32x4*)(ks_ + (lrow + 32 * j) * 144 + lch * 16) = rk[j];
#pragma unroll
    for (int j = 0; j < 2; ++j) *(u32x4*)(ks_ + 9216 + (lrow + 32 * j) * 144 + ((lch ^ ((lrow >> 3) & 3)) * 16)) = rv[j];
  };
  const int x16 = ((l31 >> 3) & 3) << 4;
  gload(0); sstore(0); __syncthreads();
  for (int it = 0; it < ntl; ++it) {
    if (it + 1 < ntl) gload(it + 1);
    {
      const unsigned char* ks_ = smem + (it & 1) * BUFB;
      const unsigned char* vs_ = ks_ + 9216;
      f32x16 s[2][2];
      __builtin_amdgcn_s_setprio(1);
#pragma unroll
      for (int kb = 0; kb < 2; ++kb)
#pragma unroll
        for (int ks = 0; ks < 4; ++ks) {
          bf16x8 a = *(const bf16x8*)(ks_ + (kb * 32 + l31) * 144 + (ks * 16 + half * 8) * 2);
#pragma unroll
          for (int qb = 0; qb < 2; ++qb) {
            if (ks == 0) {
#pragma unroll
              for (int r = 0; r < 16; ++r) s[qb][kb][r] = -m_run[qb];
            }
            s[qb][kb] = mfma32(a, qf[qb][ks], s[qb][kb]);
          }
        }
      __builtin_amdgcn_s_setprio(0);
      const bool first = (it == 0);
#pragma unroll
      for (int qb = 0; qb < 2; ++qb) {
        float mx = s[qb][0][0];
#pragma unroll
        for (int kb = 0; kb < 2; ++kb)
#pragma unroll
          for (int r = 0; r < 16; ++r) mx = fmaxf(mx, s[qb][kb][r]);
        if (first || __any(mx > 8.0f)) {
          mx = fmaxf(mx, shx(mx, 32, lane));
          const float delta = first ? mx : fmaxf(mx, 0.f);
          const float alpha = first ? 0.f : fexp2(-delta);
          m_run[qb] += delta;
#pragma unroll
          for (int kb = 0; kb < 2; ++kb)
#pragma unroll
            for (int r = 0; r < 16; ++r) s[qb][kb][r] -= delta;
          l_run[qb] *= alpha;
#pragma unroll
          for (int db = 0; db < 2; ++db)
#pragma unroll
            for (int r = 0; r < 16; ++r) oacc[qb][db][r] *= alpha;
        }
        float ps = 0.f;
#pragma unroll
        for (int kb = 0; kb < 2; ++kb)
#pragma unroll
          for (int r = 0; r < 16; ++r) { const float pe = fexp2(s[qb][kb][r]); s[qb][kb][r] = pe; ps += pe; }
        l_run[qb] += ps;
      }
#pragma unroll
      for (int kb = 0; kb < 2; ++kb)
#pragma unroll
        for (int j = 0; j < 2; ++j) {
          __builtin_amdgcn_sched_barrier(0);
          bf16x8 pb[2];
#pragma unroll
          for (int qb = 0; qb < 2; ++qb) {
            u32x4 pw = {pk2(s[qb][kb][8 * j + 0], s[qb][kb][8 * j + 1]), pk2(s[qb][kb][8 * j + 2], s[qb][kb][8 * j + 3]),
                        pk2(s[qb][kb][8 * j + 4], s[qb][kb][8 * j + 5]), pk2(s[qb][kb][8 * j + 6], s[qb][kb][8 * j + 7])};
            pb[qb] = __builtin_bit_cast(bf16x8, pw);
          }
#pragma unroll
          for (int db = 0; db < 2; ++db) {
            const unsigned char* va = vs_ + (db * 32 + l31) * 144 + half * 8;
            u32x2 v0 = *(const u32x2*)(va + (((kb * 4 + j * 2) << 4) ^ x16)), v1 = *(const u32x2*)(va + (((kb * 4 + j * 2 + 1) << 4) ^ x16));
            u32x4 vw = {v0[0], v0[1], v1[0], v1[1]};
            const bf16x8 vf = __builtin_bit_cast(bf16x8, vw);
            __builtin_amdgcn_s_setprio(1);
            oacc[0][db] = mfma32(vf, pb[0], oacc[0][db]);
            oacc[1][db] = mfma32(vf, pb[1], oacc[1][db]);
            __builtin_amdgcn_s_setprio(0);
          }
        }
    }
    if (it + 1 < ntl) sstore((it + 1) & 1);
    __syncthreads();
  }
  l_out[0] = l_run[0] + shx(l_run[0], 32, lane);
  l_out[1] = l_run[1] + shx(l_run[1], 32, lane);
}

template <int NDB>
DI void store_o(const f32x16 (&o)[NDB], bf16_t* orow, int half) {
#pragma unroll
  for (int db = 0; db < NDB; ++db)
#pragma unroll
    for (int g = 0; g < 4; ++g)
      *(u32x2*)(orow + db * 32 + 8 * g + 4 * half) = (u32x2){pk2(o[db][4 * g], o[db][4 * g + 1]), pk2(o[db][4 * g + 2], o[db][4 * g + 3])};
}

DI void attn_a_phase(const Params& p, unsigned char* smem) {
  const int tid = get_tid(), lane = tid & 63, wid = tid >> 6, l31 = lane & 31, half = lane >> 5;
  const bf16_t* Qb = (const bf16_t*)(p.ws + OFF_QKV);
  const bf16_t* Kb = Qb + (size_t)MTOT * 1024;
  const bf16_t* VTb = Kb + (size_t)MTOT * 256;
  bf16_t* O = (bf16_t*)(p.ws + OFF_H);
  const int nitems = NB * 4 * 9 * 4;
  for (int item = get_bid(); item < nitems; item += gridDim.x) {
    const int g = item & 3, qb = (item >> 2) % 9, bk = item / 36, kvh = bk & 3, b = bk >> 2;
    const int qh = kvh * 4 + g;
    int qP, nt, orow0;
    if (qb < 8) { qP = b * TP + CL + qb * 256; nt = 36; orow0 = b * TL + qb * 256; }
    else { qP = b * TP; nt = 4; orow0 = MLAT + b * CL; }
    f32x16 oacc[2][2]; float l[2];
    const bf16_t* q0 = Qb + (size_t)(qP + wid * 64 + l31) * 1024 + qh * 64;
    flash_core_q64(oacc, l, q0, q0 + 32 * 1024, Kb + (size_t)b * TP * 256 + kvh * 64, 256, VTb + (size_t)(b * 256 + kvh * 64) * TP, TP, nt, smem);
#pragma unroll
    for (int qq = 0; qq < 2; ++qq) {
      const float inv = 1.0f / l[qq];
#pragma unroll
      for (int db = 0; db < 2; ++db)
#pragma unroll
        for (int r = 0; r < 16; ++r) oacc[qq][db][r] *= inv;
      store_o<2>(oacc[qq], O + (size_t)(orow0 + wid * 64 + qq * 32 + l31) * 1024 + qh * 64, half);
    }
  }
}

DI void attn_b_phase(const Params& p, unsigned char* smem) {
  const int tid = get_tid(), lane = tid & 63, wid = tid >> 6, l31 = lane & 31, half = lane >> 5;
  const bf16_t* Qb = (const bf16_t*)(p.ws + OFF_QKV);
  const bf16_t* Kb = Qb + (size_t)MTOT * 1024;
  const bf16_t* VTb = Kb + (size_t)MTOT * 1024;
  bf16_t* O = (bf16_t*)(p.ws + OFF_H);
  float d1 = 0.f, d2 = 0.f;
  for (int e = 0; e < 64; ++e) { d1 += p.in[I_BLQ1][e] * p.in[I_BLK1][e]; d2 += p.in[I_BLQ2][e] * p.in[I_BLK2][e]; }
  const float lam = __expf(d1) - __expf(d2) + LAM_INIT_B;
  const float* subln = p.in[I_BSUB];
  const int nitems = NB * 8 * 18;
  for (int item = get_bid(); item < nitems; item += gridDim.x) {
    const int qb = item % 18, h = (item / 18) & 7, b = item / 144;
    int qP, nt, orow0;
    if (qb < 16) { qP = b * TP + CL + qb * 128; nt = 36; orow0 = b * TL + qb * 128; }
    else { qP = b * TP + (qb - 16) * 128; nt = 4; orow0 = MLAT + b * CL + (qb - 16) * 128; }
    bf16_t* orow = O + (size_t)(orow0 + wid * 32 + l31) * 1024 + h * 128;
    const bf16_t* vt = VTb + (size_t)(b * 1024 + h * 128) * TP;
    f32x16 oacc[4]; float l;
    flash_core<128, false>(oacc, l, Qb + (size_t)(qP + wid * 32 + l31) * 1024 + h * 128, Kb + (size_t)b * TP * 1024 + h * 128, 1024,
                           vt, TP, 0, nt, 0, 0, smem, 0, 0, 0, nullptr, 0);
    {
      const float inv = 1.0f / l;
#pragma unroll
      for (int db = 0; db < 4; ++db)
#pragma unroll
        for (int r = 0; r < 16; ++r) oacc[db][r] *= inv;
      store_o<4>(oacc, orow, half);
    }
    flash_core<128, false>(oacc, l, Qb + (size_t)(qP + wid * 32 + l31) * 1024 + h * 128 + 64, Kb + (size_t)b * TP * 1024 + h * 128 + 64, 1024,
                           vt, TP, 0, nt, 0, 0, smem, 0, 0, 0, nullptr, 0);
    {
      const float inv = lam / l;
      float ss = 0.f;
#pragma unroll
      for (int db = 0; db < 4; ++db)
#pragma unroll
        for (int g = 0; g < 4; ++g) {
          u32x2 o1 = *(const u32x2*)(orow + db * 32 + 8 * g + 4 * half);
          const float a0 = bflo(o1[0]), a1 = bfhi(o1[0]), a2 = bflo(o1[1]), a3 = bfhi(o1[1]);
          float v0 = a0 - oacc[db][4 * g] * inv, v1 = a1 - oacc[db][4 * g + 1] * inv, v2 = a2 - oacc[db][4 * g + 2] * inv, v3 = a3 - oacc[db][4 * g + 3] * inv;
          oacc[db][4 * g] = v0; oacc[db][4 * g + 1] = v1; oacc[db][4 * g + 2] = v2; oacc[db][4 * g + 3] = v3;
          ss += (v0 * v0 + v1 * v1) + (v2 * v2 + v3 * v3);
        }
      ss += shx(ss, 32, lane);
      const float rinv = rsqrtf(ss * (1.0f / 128.0f) + 1e-6f) * (1.0f - LAM_INIT_B);
#pragma unroll
      for (int db = 0; db < 4; ++db)
#pragma unroll
        for (int g = 0; g < 4; ++g) {
          f32x4 sg = *(const f32x4*)(subln + db * 32 + 8 * g + 4 * half);
#pragma unroll
          for (int e = 0; e < 4; ++e) oacc[db][4 * g + e] *= rinv * sg[e];
        }
      store_o<4>(oacc, orow, half);
    }
  }
}

DI void attn_d_phase(const Params& p, unsigned char* smem) {
  const int tid = get_tid(), lane = tid & 63, wid = tid >> 6, l31 = lane & 31, half = lane >> 5;
  const bf16_t* Qb = (const bf16_t*)(p.ws + OFF_QKV);
  const bf16_t* Kb = Qb + (size_t)MTOT * 1024;
  const bf16_t* VTb = Kb + (size_t)MTOT * 1024;
  bf16_t* O = (bf16_t*)(p.ws + OFF_H);
  float* rpbL = (float*)(smem + 57344);
  const int nitems = NB * 16 * 16;
  for (int item = get_bid(); item < nitems; item += gridDim.x) {
    const int rp = item & 15, h = (item >> 4) & 15, b = item >> 8;
    const int ra = 2 * rp, rb = 2 * rp + 1;
    const int r0a = iclamp(ra - 4, 0, 24), r0b = iclamp(rb - 4, 0, 24);
    const int rq = wid < 2 ? ra : rb, r0q = wid < 2 ? r0a : r0b;
    const int nband = r0b + 8 - r0a;
    for (int e = tid; e < 465; e += NTHREADS) rpbL[e] = p.in[I_DRPB][h * 465 + e] * LOG2E;
    const int qP = b * TP + CL + rp * 128, orow0 = b * TL + rp * 128;
    f32x16 oacc[2]; float l;
    flash_core<64, true>(oacc, l, Qb + (size_t)(qP + wid * 32 + l31) * 1024 + h * 64, Kb + (size_t)b * TP * 1024 + h * 64, 1024,
                         VTb + (size_t)(b * 1024 + h * 64) * TP, TP, 0, 4, CL + r0a * 64, nband, smem, rq, r0q, r0a, rpbL, (wid & 1) * 32 + l31);
    const float inv = 1.0f / l;
#pragma unroll
    for (int db = 0; db < 2; ++db)
#pragma unroll
      for (int r = 0; r < 16; ++r) oacc[db][r] *= inv;
    store_o<2>(oacc, O + (size_t)(orow0 + wid * 32 + l31) * 1024 + h * 64, half);
  }
}

DI void gla_scan_phase(const Params& p, unsigned char* smem) {
  const int tid0 = get_tid();
  const bf16_t* Qb = (const bf16_t*)(p.ws + OFF_QKV);
  const bf16_t* Kb = Qb + (size_t)MTOT * 512;
  const bf16_t* VTb = Kb + (size_t)MTOT * 512;
  const float* ZB = (const float*)(p.ws + OFF_ZB);
  unsigned char* qs = smem;
  unsigned char* ks = smem + 17408;
  unsigned char* kT = smem + 34816;
  unsigned char* vs = smem + 53248;
  float* zs = (float*)(smem + 71680);
  float* gs = (float*)(smem + 75776);
  float* eb = (float*)(smem + 76800);
  unsigned char* As = smem;
  for (int item = get_bid(); item < 512; item += gridDim.x) {
    const int vsl = item & 1, dir = (item >> 1) & 1, h = (item >> 2) & 3, b = item >> 4;
    const float* wg0 = (dir ? p.in[I_CGB] : p.in[I_CGF]) + h * 128;
    const float* gbp0 = (dir ? p.in[I_CBB] : p.in[I_CBF]) + h * 128;
    bf16_t* OUT = (bf16_t*)(p.ws + (dir ? OFF_Y : OFF_H));
    const size_t bP = (size_t)b * TP;
    f32x16 sacc[4];
#pragma unroll
    for (int kb = 0; kb < 4; ++kb)
#pragma unroll
      for (int r = 0; r < 16; ++r) sacc[kb][r] = 0.f;
    f32x4 pz; u32x4 pq[4], pk[4], pv[4];
    float wgt[16];
    { const int d0 = tid0 & 127;
#pragma unroll
      for (int r = 0; r < 16; ++r) wgt[r] = wg0[r * 512 + d0]; }
    const float gbias = gbp0[tid0 & 127];
    for (int c = 0; c < 36; ++c) {
      int base, sgn;
      if (!dir) { base = 64 * c; sgn = 1; } else { base = (c < 4) ? 255 - 64 * c : 2303 - 64 * (c - 4); sgn = -1; }
      const int tid = launder(tid0), lane = tid & 63, w = tid >> 6, l31 = lane & 31, half = lane >> 5, d = tid & 127, tg = tid >> 7;
#define GLA_FETCH(cc) { \
        int base_, sgn_; \
        if (!dir) { base_ = 64 * (cc); sgn_ = 1; } else { base_ = ((cc) < 4) ? 255 - 64 * (cc) : 2303 - 64 * ((cc) - 4); sgn_ = -1; } \
        { const int pp = tid >> 2, r4 = tid & 3; pz = *(const f32x4*)(ZB + (bP + base_ + sgn_ * pp) * 32 + dir * 16 + r4 * 4); } \
        _Pragma("unroll") for (int j = 0; j < 4; ++j) { \
          const int idx = tid + 256 * j, pp = idx >> 4, ch = idx & 15; \
          const size_t row = bP + base_ + sgn_ * pp; \
          pq[j] = *(const u32x4*)(Qb + row * 512 + h * 128 + ch * 8); \
          pk[j] = *(const u32x4*)(Kb + row * 512 + h * 128 + ch * 8); } \
        _Pragma("unroll") for (int j = 0; j < 4; ++j) { \
          const int idx = tid + 256 * j, row = idx >> 3, ch = idx & 7; \
          const bf16_t* src = VTb + ((size_t)(b * 1024 + h * 256 + vsl * 128 + row)) * TP; \
          pv[j] = (!dir) ? *(const u32x4*)(src + base_ + ch * 8) : *(const u32x4*)(src + base_ - 8 * ch - 7); } }
      if (c == 0) GLA_FETCH(0);
      { const int pp = tid >> 2, r4 = tid & 3; *(f32x4*)(zs + pp * 16 + r4 * 4) = pz; }
#pragma unroll
      for (int j = 0; j < 4; ++j) {
        const int idx = tid + 256 * j, pp = idx >> 4, ch = idx & 15;
        *(u32x4*)(qs + pp * 272 + ch * 16) = pq[j];
        *(u32x4*)(ks + pp * 272 + ch * 16) = pk[j];
      }
#pragma unroll
      for (int j = 0; j < 4; ++j) {
        const int idx = tid + 256 * j, row = idx >> 3, ch = idx & 7;
        u32x4 t = pv[j];
        u32x4 v = (!dir) ? t : (u32x4){(t[3] >> 16) | (t[3] << 16), (t[2] >> 16) | (t[2] << 16), (t[1] >> 16) | (t[1] << 16), (t[0] >> 16) | (t[0] << 16)};
        *(u32x4*)(vs + row * 144 + ch * 16) = v;
      }
      if (c + 1 < 36) GLA_FETCH(c + 1);
#undef GLA_FETCH
      __syncthreads();
      {
        float g[32];
        float tot = 0.f;
#pragma unroll
        for (int pp = 0; pp < 32; ++pp) {
          const float* z = zs + (tg * 32 + pp) * 16;
          float a = gbias;
#pragma unroll
          for (int r4 = 0; r4 < 4; ++r4) {
            f32x4 zv = *(const f32x4*)(z + r4 * 4);
            a += zv[0] * wgt[r4 * 4] + zv[1] * wgt[r4 * 4 + 1] + zv[2] * wgt[r4 * 4 + 2] + zv[3] * wgt[r4 * 4 + 3];
          }
          const float ls = fminf(a, 0.f) - __logf(1.0f + __expf(-fabsf(a)));
          g[pp] = ls * (1.0f / 16.0f);
          tot += g[pp];
        }
        gs[tg * 128 + d] = tot;
        __syncthreads();
        const float t0 = gs[d], t1 = gs[128 + d];
        const float blast = t0 + t1;
        const float eblast = __expf(blast);
        if (tg == 0) eb[d] = eblast;
        float run = tg ? t0 : 0.f;
#pragma unroll
        for (int pp = 0; pp < 32; pp += 2) {
          unsigned kTw = 0;
#pragma unroll
          for (int e = 0; e < 2; ++e) {
            const int tp = tg * 32 + pp + e;
            run += g[pp + e];
            const float eq = __expf(run), eki = __expf(-run);
            bf16_t* qa = (bf16_t*)(qs + tp * 272 + d * 2);
            bf16_t* ka = (bf16_t*)(ks + tp * 272 + d * 2);
            const float qv = bf2f(*qa), kv = bf2f(*ka);
            *qa = (bf16_t)(pk2(qv * eq, 0.f) & 0xffffu);
            *ka = (bf16_t)(pk2(kv * eki, 0.f) & 0xffffu);
            const unsigned kt = pk2(kv * eki * eblast, 0.f) & 0xffffu;
            kTw |= kt << (16 * e);
          }
          *(unsigned*)(kT + d * 144 + (tg * 32 + pp) * 2) = kTw;
        }
      }
      __syncthreads();
      __builtin_amdgcn_sched_barrier(0);
      f32x16 aacc, oacc[2];
#pragma unroll
      for (int r = 0; r < 16; ++r) { aacc[r] = 0.f; oacc[0][r] = 0.f; oacc[1][r] = 0.f; }
      const int bi = w >> 1, bj = w & 1;
      if (w != 1) {
#pragma unroll
        for (int k8 = 0; k8 < 8; ++k8) {
          bf16x8 a = *(const bf16x8*)(qs + (32 * bi + l31) * 272 + (16 * k8 + 8 * half) * 2);
          bf16x8 bb = *(const bf16x8*)(ks + (32 * bj + l31) * 272 + (16 * k8 + 8 * half) * 2);
          aacc = mfma32(a, bb, aacc);
        }
#pragma unroll
        for (int r = 0; r < 16; ++r) {
          const int i = 32 * bi + 8 * (r >> 2) + 4 * half + (r & 3), jx = 32 * bj + l31;
          aacc[r] = (jx <= i) ? aacc[r] : 0.f;
        }
      }
#pragma unroll
      for (int kb = 0; kb < 4; ++kb)
#pragma unroll
        for (int j = 0; j < 2; ++j) {
          __builtin_amdgcn_sched_barrier(0);
          u32x4 sw = {pk2(sacc[kb][8 * j + 0], sacc[kb][8 * j + 1]), pk2(sacc[kb][8 * j + 2], sacc[kb][8 * j + 3]),
                      pk2(sacc[kb][8 * j + 4], sacc[kb][8 * j + 5]), pk2(sacc[kb][8 * j + 6], sacc[kb][8 * j + 7])};
          const bf16x8 sb = __builtin_bit_cast(bf16x8, sw);
#pragma unroll
          for (int tb = 0; tb < 2; ++tb) {
            const unsigned char* qa = qs + (32 * tb + l31) * 272 + (32 * kb + 16 * j + 4 * half) * 2;
            u32x2 q0 = *(const u32x2*)(qa), q1 = *(const u32x2*)(qa + 16);
            u32x4 qw = {q0[0], q0[1], q1[0], q1[1]};
            oacc[tb] = mfma32(__builtin_bit_cast(bf16x8, qw), sb, oacc[tb]);
          }
        }
      __syncthreads();
#pragma unroll
      for (int r = 0; r < 16; ++r) {
        const int i = 32 * bi + 8 * (r >> 2) + 4 * half + (r & 3), jx = 32 * bj + l31;
        *(bf16_t*)(As + i * 144 + jx * 2) = (bf16_t)(pk2(aacc[r], 0.f) & 0xffffu);
      }
      __syncthreads();
      __builtin_amdgcn_sched_barrier(0);
      bf16x8 vfr[4];
#pragma unroll
      for (int k4 = 0; k4 < 4; ++k4) vfr[k4] = *(const bf16x8*)(vs + (32 * w + l31) * 144 + (16 * k4 + 8 * half) * 2);
#pragma unroll
      for (int tb = 0; tb < 2; ++tb)
#pragma unroll
        for (int k4 = 0; k4 < 4; ++k4) {
          bf16x8 a = *(const bf16x8*)(As + (32 * tb + l31) * 144 + (16 * k4 + 8 * half) * 2);
          oacc[tb] = mfma32(a, vfr[k4], oacc[tb]);
        }
#pragma unroll
      for (int tb = 0; tb < 2; ++tb)
#pragma unroll
        for (int r = 0; r < 16; ++r) {
          const int tp = 32 * tb + 8 * (r >> 2) + 4 * half + (r & 3);
          const int kidx = base + sgn * tp;
          const int urow = kidx < CL ? MLAT + b * CL + kidx : b * TL + kidx - CL;
          OUT[(size_t)urow * 1024 + h * 256 + vsl * 128 + 32 * w + l31] = (bf16_t)(pk2(oacc[tb][r], 0.f) & 0xffffu);
        }
#pragma unroll
      for (int kb = 0; kb < 4; ++kb) {
        __builtin_amdgcn_sched_barrier(0);
#pragma unroll
        for (int g4 = 0; g4 < 4; ++g4) {
          f32x4 e4 = *(const f32x4*)(eb + 32 * kb + 8 * g4 + 4 * half);
#pragma unroll
          for (int e = 0; e < 4; ++e) sacc[kb][4 * g4 + e] *= e4[e];
        }
#pragma unroll
        for (int k4 = 0; k4 < 4; ++k4) {
          bf16x8 a = *(const bf16x8*)(kT + (32 * kb + l31) * 144 + (16 * k4 + 8 * half) * 2);
          sacc[kb] = mfma32(a, vfr[k4], sacc[kb]);
        }
      }
      __syncthreads();
    }
  }
}


#define XB_TMO      128
#define XB_XCNT(j)  (256  + 64 * (j))
#define XB_XSUB(j)  (1280 + 64 * (j))
#define XB_XGEN(j)  (2304 + 64 * (j))
#define XB_TOP      3328
#define XB_TOPGEN   3392
#define XCD_BAR_WORDS 3456
#define XB_SPIN_CAP (1u << 20)
#define LAS __attribute__((address_space(3)))
DI unsigned xb_ld(unsigned* p) { return __hip_atomic_load(p, __ATOMIC_RELAXED, __HIP_MEMORY_SCOPE_AGENT); }
DI unsigned xb_add(unsigned* p, unsigned v) { return __hip_atomic_fetch_add(p, v, __ATOMIC_RELAXED, __HIP_MEMORY_SCOPE_AGENT); }
DI unsigned xb_xcc_id() { return (unsigned)__builtin_amdgcn_s_getreg((3 << 11) | 20) & 0xFu; }
#define XB_SPIN(cond, bar) do { unsigned _sp = 0; while (cond) { __builtin_amdgcn_s_sleep(1); \
    if ((++_sp & 255u) == 0u) { if (xb_ld(&(bar)[XB_TMO])) break; if (_sp > XB_SPIN_CAP) { atomicAdd(&(bar)[XB_TMO], 1u); break; } } } } while (0)
struct XcdBarrier { unsigned* bar; unsigned x; volatile LAS unsigned* st; };
DI XcdBarrier xcd_barrier_post(unsigned* bar, volatile LAS unsigned* st) {
  XcdBarrier b; b.bar = bar; b.x = xb_xcc_id(); b.st = st;
  if (threadIdx.x == 0) (void)xb_add(&bar[XB_XCNT(b.x)], 1u);
  return b;
}
DI void xcd_barrier_complete(unsigned* bar, unsigned x, unsigned& nloc, unsigned& nx) {
  const unsigned G = gridDim.x * gridDim.y * gridDim.z;
  unsigned sum, cnt, mine, sp = 0u;
  for (;;) {
    sum = 0u; cnt = 0u; mine = 0u;
#pragma unroll
    for (unsigned j = 0; j < 16; ++j) { const unsigned c = xb_ld(&bar[XB_XCNT(j)]); sum += c; cnt += (c > 0u) ? 1u : 0u; mine = (j == x) ? c : mine; }
    if (sum == G) break;
    __builtin_amdgcn_s_sleep(1);
    if ((++sp & 255u) == 0u) { if (xb_ld(&bar[XB_TMO])) break; if (sp > XB_SPIN_CAP) { atomicAdd(&bar[XB_TMO], 1u); break; } }
  }
  nloc = mine > 0u ? mine : 1u; nx = cnt > 0u ? cnt : 1u;
}
DI void xcd_barrier(unsigned char* ws, volatile LAS unsigned* st_) {
  XcdBarrier b; b.bar = (unsigned*)(ws + OFF_BAR); b.x = xb_xcc_id(); b.st = st_;
  asm volatile("s_waitcnt vmcnt(0)" ::: "memory");
  __syncthreads();
  if (threadIdx.x == 0) {
    unsigned* bar = b.bar;
    __builtin_amdgcn_s_waitcnt(0);
    unsigned nloc = b.st[0], nx = b.st[1];
    if (nloc == 0u) { xcd_barrier_complete(bar, b.x, nloc, nx); b.st[0] = nloc; b.st[1] = nx; }
    const unsigned old = xb_add(&bar[XB_XSUB(b.x)], 1u);
    const unsigned gen = old / nloc;
    if (old + 1u == (gen + 1u) * nloc) {
      __builtin_amdgcn_fence(__ATOMIC_RELEASE, "agent");
      asm volatile("s_waitcnt vmcnt(0)" ::: "memory");
      const unsigned og = xb_add(&bar[XB_TOP], 1u);
      const unsigned tg = og / nx;
      if (og + 1u == (tg + 1u) * nx) xb_add(&bar[XB_TOPGEN], 1u);
      else XB_SPIN(xb_ld(&bar[XB_TOPGEN]) == tg, bar);
      __builtin_amdgcn_fence(__ATOMIC_ACQUIRE, "agent");
      xb_add(&bar[XB_XGEN(b.x)], 1u);
      asm volatile("s_waitcnt vmcnt(0)" ::: "memory");
    } else {
      XB_SPIN(xb_ld(&bar[XB_XGEN(b.x)]) == gen, bar);
      __builtin_amdgcn_fence(__ATOMIC_ACQUIRE, "agent");
      asm volatile("s_waitcnt vmcnt(0)" ::: "memory");
    }
  }
  __syncthreads();
}

__global__ void __launch_bounds__(NTHREADS, 2) fwd_megakernel(Params p, int ph_lo, int ph_hi) {
  __shared__ __attribute__((aligned(16))) unsigned char smem[SMEM_BYTES];
  __shared__ uint4 xb_words;
  cg::grid_group grid = cg::this_grid();
  if (threadIdx.x == 0) xb_words = make_uint4(0u, 0u, 0u, 0u);
  __syncthreads();
  (void)xcd_barrier_post((unsigned*)(p.ws + OFF_BAR), (volatile LAS unsigned*)&xb_words);
  {
    const int nmod = 384, ntr = p.wtile0[16];
    for (int it = get_bid(); it < nmod + 1 + ntr; it += gridDim.x) {
      if (it < nmod) mod_item(p, it, smem);
      else if (it == nmod) rope_item(p);
      else transpose_item(p, it - nmod - 1, smem);
    }
    if (ph_hi > 4096) grid.sync();
    xcd_barrier(p.ws, (volatile LAS unsigned*)&xb_words);
  }
  for (int step = ph_lo + 1; step < ph_hi; ++step) {
    int kind, layer;
    if (step < 2) { kind = step; layer = 0; } else { layer = (step - 2) >> 3; kind = 2 + ((step - 2) & 7); }
    if (kind == 4 && layer != 2) continue;
    const bool last = layer == 3;
    const bf16_t* WT = (const bf16_t*)(p.ws + OFF_WT);
    const float* MOD = (const float*)(p.ws + OFF_MOD);
    float* XC = (float*)(p.ws + OFF_XC);
    const float* modl = MOD + (size_t)layer * 33 * 6144;
    const int nrows = last ? MLAT : MTOT;
    if (kind == 0) {
    } else if (kind == 1) {
      modulate_phase(p);
    } else if (kind == 2) {
      QkvCfg cfg;
      if (layer == 0) cfg = {0, 1024, 256, 256, 12, 0.125f * LOG2E};
      else if (layer == 1) cfg = {1, 1024, 1024, 1024, 24, 0.125f * LOG2E};
      else if (layer == 2) cfg = {2, 512, 512, 1024, 25, 0.08838834764831845f};
      else cfg = {3, 1024, 1024, 1024, 24, 0.125f * LOG2E};
      gemm_qkv_phase(p, cfg, WT + p.wdst[layer * 4 + 0], p.in[I_AQN], p.in[I_AKN], smem);
    } else if (kind == 3) {
      if (layer == 0) attn_a_phase(p, smem);
      else if (layer == 1) attn_b_phase(p, smem);
      else if (layer == 2) gla_scan_phase(p, smem);
      else attn_d_phase(p, smem);
    } else if (kind == 4) {
      gla_finish_phase(p);
    } else if (kind == 5 || kind == 8) {
      const bool dn = kind == 8;
      gemm_plain_phase(p, dn ? (const bf16_t*)(p.ws + OFF_QKV) : (const bf16_t*)(p.ws + OFF_H), dn ? FF : 1024,
                       WT + p.wdst[layer * 4 + (dn ? 3 : 1)], (bf16_t*)(p.ws + OFF_Y), nrows / 256, smem);
    } else if (kind == 6 || kind == 9) {
      const bool second = kind == 9;
      const bool first_in = (!second) && layer == 0;
      ln_phase(p, first_in ? p.in[I_X] : p.out, first_in ? p.in[I_CTX] : XC, p.out, XC, modl, second ? 5 : 2,
               (second ? p.in[I_LN2G] : p.in[I_LN1G]) + layer * 1024, (second ? p.in[I_LN2B] : p.in[I_LN1B]) + layer * 1024,
               second ? modl + (size_t)33 * 6144 : modl, second ? 0 : 3, second ? 1 : 4, nrows, second ? !last : true);
    } else {
      gemm_ffn_up_phase(p, layer, WT + p.wdst[layer * 4 + 2], !last, smem);
    }
    if (step + 1 < ph_hi) {
      xcd_barrier(p.ws, (volatile LAS unsigned*)&xb_words);
    }
  }
}

extern "C" void kernel_launch(void* const* d_in, const int* in_sizes, int n_in, void* d_out, int out_size, void* d_ws, size_t ws_size,
                              hipStream_t stream) {
  static int grid_blocks = 0;
  if (!grid_blocks) {
    int dev = 0, cus = 0, per_cu = 0;
    hipGetDevice(&dev);
    hipDeviceGetAttribute(&cus, hipDeviceAttributeMultiprocessorCount, dev);
    hipOccupancyMaxActiveBlocksPerMultiprocessor(&per_cu, fwd_megakernel, NTHREADS, 0);
    if (per_cu > 2) per_cu = 2;
    grid_blocks = cus * per_cu;
    if (ws_size < WS_NEED) fprintf(stderr, "workspace too small: %zu < %zu\n", ws_size, (size_t)WS_NEED);
  }
  Params p;
  memset(&p, 0, sizeof(p));
  for (int i = 0; i < 35; ++i) p.in[i] = (const float*)d_in[i];
  p.out = (float*)d_out;
  p.ws = (unsigned char*)d_ws;
  const int qkvN[4] = {1536, 3072, 3104, 3072}, qkvNp[4] = {1536, 3072, 3200, 3072};
  const int qkvI[4] = {I_AQKV, I_BQKV, I_CWIN, I_DQKV}, woI[4] = {I_AWO, I_BWO, I_CWO, I_DWO};
  long off = 0; int t0 = 0;
  for (int l = 0; l < 4; ++l) {
    for (int k = 0; k < 4; ++k) {
      const int mi = l * 4 + k;
      int K, N, Np, mode = 0; const float* src;
      if (k == 0) { K = 1024; N = qkvN[l]; Np = qkvNp[l]; src = (const float*)d_in[qkvI[l]]; }
      else if (k == 1) { K = 1024; N = 1024; Np = 1024; src = (const float*)d_in[woI[l]]; }
      else if (k == 2) { K = 1024; N = 5632; Np = 5632; mode = 1; src = (const float*)d_in[I_UPW] + (size_t)l * 1024 * 5632; }
      else { K = 2816; N = 1024; Np = 1024; src = (const float*)d_in[I_DOWNW] + (size_t)l * 2816 * 1024; }
      p.wsrc[mi] = src; p.wdst[mi] = off; p.wK[mi] = K; p.wN[mi] = N; p.wNpad[mi] = Np; p.wmode[mi] = mode; p.wtile0[mi] = t0;
      off += (long)Np * K; t0 += (K / 64) * (Np / 64);
    }
  }
  p.wtile0[16] = t0;
  int lo = 0, hi = 34;
  hipMemsetAsync((unsigned char*)d_ws + OFF_BAR, 0, XCD_BAR_WORDS * sizeof(unsigned), stream);
  void* args[] = {&p, &lo, &hi};
  hipError_t e = hipLaunchCooperativeKernel((void*)fwd_megakernel, dim3(grid_blocks), dim3(NTHREADS), args, 0, stream);
  if (e != hipSuccess) fprintf(stderr, "cooperative launch failed: %s (grid %d)\n", hipGetErrorString(e), grid_blocks);
}
```
